# Optimizing an MI355X kernel written in HIP

```python
import math
import jax, jax.numpy as jnp
from jax import lax
import numpy as np

D_MODEL = 1024
BATCH = 8
SEQ = 4096
DEPTH = 1

HEAD_DIM = D_MODEL // 16
DIL_GROUPS = ((128, 1), (512, 4), (2048, 16))
N_DIL_GROUPS = len(DIL_GROUPS)
HEADS_PER_GROUP = 4
N_ATTN_HEADS = N_DIL_GROUPS * HEADS_PER_GROUP
ATTN_W = N_ATTN_HEADS * HEAD_DIM
A_OUT = HEADS_PER_GROUP * HEAD_DIM
WINDOW_STEPS = 128
Q_BLOCK = 128
SG_CHUNK = 128
SG_GROUPS = 8
SG_W = SG_GROUPS * HEAD_DIM
MEM_LEN = 256
MEM_HEADS = 4
MEM_W = MEM_HEADS * HEAD_DIM
N_BRANCH = 3
IN_W = 3 * ATTN_W + 2 * SG_W + MEM_W
SPLITS = (ATTN_W, 2 * ATTN_W, 3 * ATTN_W, 3 * ATTN_W + 2 * SG_W)
D_FF = 11 * D_MODEL // 4
CONV_W = 3
N_BUCKETS = 32
MAX_DISTANCE = 2048
LN_EPS = 1e-5
ALPHA = (2 * DEPTH) ** 0.25
BETA = (8 * DEPTH) ** -0.25
ATTN_SCALE = HEAD_DIM ** -0.5
NEG = -1e30

kernel_name = 'gated_hybrid_dilated_gmlp_memxattn_convffn'


def layer_norm(x, g, b):
    xf = x.astype(jnp.float32)
    mu = xf.mean(-1, keepdims=True)
    var = jnp.square(xf - mu).mean(-1, keepdims=True)
    return ((xf - mu) * lax.rsqrt(var + LN_EPS) * g.astype(jnp.float32) + b.astype(jnp.float32)).astype(x.dtype)


def t5_bucket(dist):
    max_exact = N_BUCKETS // 2
    n = jnp.maximum(dist, 1).astype(jnp.float32)
    large = max_exact + (jnp.log(n / max_exact) / math.log(MAX_DISTANCE / max_exact)
                         * (N_BUCKETS - max_exact)).astype(jnp.int32)
    large = jnp.minimum(large, N_BUCKETS - 1)
    return jnp.where(dist < max_exact, dist, large)


def dilated_window_attention(q, k, v, bias_tab, dilation):
    b_, s_, h_, e_ = q.shape
    L = s_ // dilation
    nb = -(-L // Q_BLOCK)
    pad = nb * Q_BLOCK - L

    def split(t):
        t = t.reshape(b_, L, dilation, h_, e_).transpose(0, 2, 3, 1, 4)
        t = jnp.pad(t, ((0, 0), (0, 0), (0, 0), (0, pad), (0, 0)))
        return t.reshape(b_, dilation, h_, nb, Q_BLOCK, e_).astype(jnp.float32)

    def with_prev(t):
        prev = jnp.pad(t, ((0, 0), (0, 0), (0, 0), (1, 0), (0, 0), (0, 0)))[:, :, :, :-1]
        return jnp.concatenate([prev, t], axis=4)

    qb = split(q)
    kb = with_prev(split(k))
    vb = with_prev(split(v))

    qi = jnp.arange(Q_BLOCK)[:, None]
    kj = jnp.arange(2 * Q_BLOCK)[None, :]
    steps = qi + Q_BLOCK - kj
    band = (steps >= 0) & (steps <= WINDOW_STEPS)
    bucket = t5_bucket(jnp.maximum(steps, 0) * dilation)
    bias = bias_tab[bucket].astype(jnp.float32).transpose(2, 0, 1)
    blk = jnp.arange(nb)[:, None, None]
    valid = band[None] & ((blk > 0) | (kj[None] >= Q_BLOCK))

    s = jnp.einsum('bdhnqe,bdhnke->bdhnqk', qb, kb) * ATTN_SCALE + bias[None, None, :, None]
    s = jnp.where(valid[None, None, None], s, NEG)
    m = s.max(-1, keepdims=True)
    p = jnp.exp(s - m)
    den = p.sum(-1, keepdims=True)
    o = jnp.einsum('bdhnqk,bdhnke->bdhnqe', p, vb) / den
    lse = (m + jnp.log(den))[..., 0]

    o = o.reshape(b_, dilation, h_, nb * Q_BLOCK, e_)[:, :, :, :L]
    o = o.transpose(0, 3, 1, 2, 4).reshape(b_, s_, h_, e_)
    lse = lse.reshape(b_, dilation, h_, nb * Q_BLOCK)[..., :L]
    lse = lse.transpose(0, 3, 1, 2).reshape(b_, s_, h_)
    return o, lse


def token_mixing_sublayer(x, mem, rel_bias, w_in, w_mem_kv, sg_ln_g, sg_ln_b, w_spatial, b_spatial,
                          w_proj_a, w_proj_b, w_proj_c, w_gate, b_gate, w_out, ln_g, ln_b):
    b_, s_, _ = x.shape
    proj = x @ w_in
    qa, ka, va, zb, qc = jnp.split(proj, SPLITS, axis=-1)

    hs = (b_, s_, N_DIL_GROUPS, HEADS_PER_GROUP, HEAD_DIM)
    qa, ka, va = qa.reshape(hs), ka.reshape(hs), va.reshape(hs)
    outs, lses = [], []
    for g, (_, dil) in enumerate(DIL_GROUPS):
        o_g, lse_g = dilated_window_attention(
            qa[:, :, g], ka[:, :, g], va[:, :, g],
            rel_bias[:, g * HEADS_PER_GROUP:(g + 1) * HEADS_PER_GROUP], dil)
        outs.append(o_g)
        lses.append(lse_g)
    wts = jax.nn.softmax(jnp.stack(lses, 0), axis=0)
    oa = (wts[..., None] * jnp.stack(outs, 0)).sum(0)
    oa = oa.reshape(b_, s_, A_OUT).astype(x.dtype)

    zb = jax.nn.gelu(zb)
    u, vg = jnp.split(zb, 2, axis=-1)
    vg = layer_norm(vg, sg_ln_g, sg_ln_b).astype(jnp.float32)
    vg = vg.reshape(b_, s_ // SG_CHUNK, SG_CHUNK, SG_GROUPS, HEAD_DIM)
    tril = jnp.tril(jnp.ones((SG_CHUNK, SG_CHUNK), jnp.float32))
    sv = jnp.einsum('gpq,bcqge->bcpge', w_spatial.astype(jnp.float32) * tril, vg)
    sv = sv + b_spatial.astype(jnp.float32).T[None, None, :, :, None]
    ob = (u.astype(jnp.float32) * sv.reshape(b_, s_, SG_W)).astype(x.dtype)

    kv = (mem @ w_mem_kv).reshape(b_, MEM_LEN, 2, MEM_HEADS, HEAD_DIM)
    kc, vc = kv[:, :, 0].astype(jnp.float32), kv[:, :, 1].astype(jnp.float32)
    qc = qc.reshape(b_, s_, MEM_HEADS, HEAD_DIM).astype(jnp.float32)
    pc = jax.nn.softmax(jnp.einsum('bshe,bmhe->bhsm', qc, kc) * ATTN_SCALE, axis=-1)
    oc = jnp.einsum('bhsm,bmhe->bshe', pc, vc).reshape(b_, s_, MEM_W).astype(x.dtype)

    gates = jax.nn.sigmoid((x @ w_gate + b_gate).astype(jnp.float32)).reshape(b_, s_, N_BRANCH, D_MODEL)
    merged = (gates[:, :, 0] * (oa @ w_proj_a).astype(jnp.float32)
              + gates[:, :, 1] * (ob @ w_proj_b).astype(jnp.float32)
              + gates[:, :, 2] * (oc @ w_proj_c).astype(jnp.float32))
    y = merged.astype(x.dtype) @ w_out
    return layer_norm(ALPHA * x + y, ln_g, ln_b)


def conv_ffn_sublayer(x, w_ffn_up, conv_w, conv_b, w_ffn_down, ln_g, ln_b):
    a, bval = jnp.split(x @ w_ffn_up, 2, axis=-1)
    a = lax.conv_general_dilated(a, conv_w[:, None, :], window_strides=(1,),
                                 padding=((CONV_W - 1, 0),),
                                 dimension_numbers=('NWC', 'WIO', 'NWC'),
                                 feature_group_count=D_FF) + conv_b
    y = (jax.nn.gelu(a) * bval) @ w_ffn_down
    return layer_norm(ALPHA * x + y, ln_g, ln_b)


def setup_inputs(seed: int = 0) -> dict:
    key = jax.random.key(seed)
    ks = jax.random.split(key, 24)
    f32 = jnp.float32

    def nrm(k, shape, scale):
        return jax.random.normal(k, shape, f32) * scale

    L = DEPTH
    in_scale = jnp.ones((IN_W,), f32).at[2 * ATTN_W:3 * ATTN_W].set(BETA)
    mem_scale = jnp.ones((2 * MEM_W,), f32).at[MEM_W:].set(BETA)
    return {
        'x': nrm(ks[0], (BATCH, SEQ, D_MODEL), 1.0),
        'mem': nrm(ks[1], (BATCH, MEM_LEN, D_MODEL), 1.0),
        'rel_bias': nrm(ks[2], (N_BUCKETS, N_ATTN_HEADS), 0.5),
        'w_in': nrm(ks[3], (L, D_MODEL, IN_W), D_MODEL ** -0.5) * in_scale,
        'w_mem_kv': nrm(ks[4], (L, D_MODEL, 2 * MEM_W), D_MODEL ** -0.5) * mem_scale,
        'sg_ln_g': 1.0 + nrm(ks[5], (L, SG_W), 0.02),
        'sg_ln_b': nrm(ks[6], (L, SG_W), 0.02),
        'w_spatial': nrm(ks[7], (L, SG_GROUPS, SG_CHUNK, SG_CHUNK), SG_CHUNK ** -0.5),
        'b_spatial': 1.0 + nrm(ks[8], (L, SG_GROUPS, SG_CHUNK), 0.1),
        'w_proj_a': nrm(ks[9], (L, A_OUT, D_MODEL), A_OUT ** -0.5 * BETA),
        'w_proj_b': nrm(ks[10], (L, SG_W, D_MODEL), SG_W ** -0.5 * BETA),
        'w_proj_c': nrm(ks[11], (L, MEM_W, D_MODEL), MEM_W ** -0.5 * BETA),
        'w_gate': nrm(ks[12], (L, D_MODEL, N_BRANCH * D_MODEL), D_MODEL ** -0.5),
        'b_gate': nrm(ks[13], (L, N_BRANCH * D_MODEL), 0.01),
        'w_out': nrm(ks[14], (L, D_MODEL, D_MODEL), D_MODEL ** -0.5 * BETA),
        'ln1_g': 1.0 + nrm(ks[15], (L, D_MODEL), 0.02),
        'ln1_b': nrm(ks[16], (L, D_MODEL), 0.02),
        'w_ffn_up': nrm(ks[17], (L, D_MODEL, 2 * D_FF), D_MODEL ** -0.5),
        'conv_w': nrm(ks[18], (L, CONV_W, D_FF), CONV_W ** -0.5),
        'conv_b': nrm(ks[19], (L, D_FF), 0.01),
        'w_ffn_down': nrm(ks[20], (L, D_FF, D_MODEL), D_FF ** -0.5 * BETA),
        'ln2_g': 1.0 + nrm(ks[21], (L, D_MODEL), 0.02),
        'ln2_b': nrm(ks[22], (L, D_MODEL), 0.02),
    }


def reference(x, mem, rel_bias, w_in, w_mem_kv, sg_ln_g, sg_ln_b, w_spatial, b_spatial,
              w_proj_a, w_proj_b, w_proj_c, w_gate, b_gate, w_out, ln1_g, ln1_b,
              w_ffn_up, conv_w, conv_b, w_ffn_down, ln2_g, ln2_b):
    h = x
    for l in range(DEPTH):
        h = token_mixing_sublayer(h, mem, rel_bias, w_in[l], w_mem_kv[l], sg_ln_g[l], sg_ln_b[l],
                                  w_spatial[l], b_spatial[l], w_proj_a[l], w_proj_b[l], w_proj_c[l],
                                  w_gate[l], b_gate[l], w_out[l], ln1_g[l], ln1_b[l])
        h = conv_ffn_sublayer(h, w_ffn_up[l], conv_w[l], conv_b[l], w_ffn_down[l], ln2_g[l], ln2_b[l])
    return h
```

```cpp
#define MK_N_LAUNCHES 1
#include <hip/hip_runtime.h>
#include <cstdio>
#include <cstdint>
namespace pg8 {
#define PG8_LAS __attribute__((address_space(3)))
typedef unsigned short bf16_t;
typedef short bf16x8 __attribute__((ext_vector_type(8)));
typedef float f32x4 __attribute__((ext_vector_type(4)));
typedef unsigned u32x4 __attribute__((ext_vector_type(4)));
constexpr int BM = 256, BK = 64, HALF = 128, HTB = HALF * BK * 2  , STAGE_BYTES = 8 * HTB, NXCD = 8, WGM = 8;

__host__ __device__ __forceinline__ int lds_byte(int r, int c) { const int st = (r >> 4) * 2 + (c >> 5), rr = r & 15, cc = c & 31, ob = rr * 64 + cc * 2; return st * 1024 + (ob ^ (((ob >> 9) & 1) << 5)); }
__host__ __device__ __forceinline__ void stage_rc(int b, int& R, int& C) { const int st = b / 1024, sb = b % 1024, swz = sb ^ (((sb >> 9) & 1) << 5); R = (st >> 1) * 16 + swz / 64; C = (st & 1) * 32 + (swz % 64) / 2; }
__host__ __device__ __forceinline__ int perm32(int rho) { const int n = rho >> 4, i = rho & 15; return 8 * (i >> 2) + 4 * n + (i & 3); }

struct Unit { int pm, pn; };
struct Gemm { const bf16_t* A; const bf16_t* Bt; int M, N, K; };

struct StaticOrder {
    int nM, nN, nwg, G, c;
    __host__ __device__ void init(int M, int N, int G_, int c_) { nM = M / BM; nN = N / BM; nwg = nM * nN; G = G_; c = c_; }
    __host__ __device__ bool next(int i, Unit& u) const {
        const long L = (long)i * G + c; if (L >= nwg) return false;
        int wgid = (int)L; { const int q = nwg / NXCD, r = nwg % NXCD, xcd = wgid % NXCD, off = wgid / NXCD; wgid = (xcd < r ? xcd * (q + 1) : r * (q + 1) + (xcd - r) * q) + off; }
        const int nig = WGM * nN, gid = wgid / nig, fm = gid * WGM, gsz = (nM - fm) < WGM ? (nM - fm) : WGM;
        u.pm = fm + ((wgid % nig) % gsz); u.pn = (wgid % nig) / gsz; return true;
    }
    __device__ __forceinline__ void a_ready(const Unit&) const {}
    __device__ __forceinline__ void done(const Unit&) const {}
};


typedef float f32x2_t __attribute__((ext_vector_type(2))); typedef __bf16 bf16x2_t __attribute__((ext_vector_type(2)));
__device__ __forceinline__ unsigned cvt_pk_bf16(float lo, float hi) { f32x2_t v = {lo, hi}; bf16x2_t b = __builtin_convertvector(v, bf16x2_t); return __builtin_bit_cast(unsigned, b); }
__device__ __forceinline__ float bflo(unsigned u) { return __uint_as_float(u << 16); }
__device__ __forceinline__ float bfhi(unsigned u) { return __uint_as_float(u & 0xffff0000u); }
__device__ __forceinline__ float sigmoid_f(float z) { return __builtin_amdgcn_rcpf(1.0f + __expf(-z)); }
__device__ __forceinline__ float gelu_tanh_f(float x) { const float u2 = 1.5957691216057308f * x * (1.0f + 0.044715f * x * x); return x * __builtin_amdgcn_rcpf(1.0f + __expf(-u2)); }

struct EpiProj {
    static constexpr bool PERM = true, AFTER_DRAIN = false;
    bf16_t* QKVA; bf16_t* ZB; bf16_t* QC;
    __device__ __forceinline__ void operator()(const f32x4 (&acc)[2][2][4][2], const Unit& u, int wr, int wc, int fr, int fq) const {
        const int pn = u.pn; bf16_t* base; int ldc, colt, mode;
        if (pn < 9) { base = QKVA; ldc = 2304; colt = pn * 256; mode = pn < 3 ? 1 : 0; }
        else if (pn < 13) { base = ZB; ldc = 1024; colt = (pn - 9) * 256; mode = 2; }
        else { base = QC; ldc = 256; colt = 0; mode = 1; }
        const int row0 = u.pm * BM + wr * 64 + fr, col0 = colt + wc * 32 + 8 * fq;
#pragma unroll
        for (int ai = 0; ai < 2; ++ai)
#pragma unroll
            for (int m = 0; m < 4; ++m) { bf16_t* rowp = base + (size_t)(row0 + ai * HALF + m * 16) * ldc + col0;
#pragma unroll
                for (int bj = 0; bj < 2; ++bj) { f32x4 v0 = acc[ai][bj][m][0], v1 = acc[ai][bj][m][1];
                    if (mode == 2) {
#pragma unroll
                        for (int i = 0; i < 4; ++i) { v0[i] = gelu_tanh_f(v0[i]); v1[i] = gelu_tanh_f(v1[i]); } }
                    else if (mode == 1) { v0 = v0 * 0.125f; v1 = v1 * 0.125f; }
                    u32x4 w; w.x = cvt_pk_bf16(v0[0], v0[1]); w.y = cvt_pk_bf16(v0[2], v0[3]); w.z = cvt_pk_bf16(v1[0], v1[1]); w.w = cvt_pk_bf16(v1[2], v1[3]);
                    *(u32x4*)(rowp + bj * HALF) = w; } }
    }
};
struct EpiPlain {
    static constexpr bool PERM = true, AFTER_DRAIN = false;
    bf16_t* O; int ldc;
    __device__ __forceinline__ void operator()(const f32x4 (&acc)[2][2][4][2], const Unit& u, int wr, int wc, int fr, int fq) const {
        const int row0 = u.pm * BM + wr * 64 + fr, col0 = u.pn * BM + wc * 32 + 8 * fq;
#pragma unroll
        for (int ai = 0; ai < 2; ++ai)
#pragma unroll
            for (int m = 0; m < 4; ++m) { bf16_t* rowp = O + (size_t)(row0 + ai * HALF + m * 16) * ldc + col0;
#pragma unroll
                for (int bj = 0; bj < 2; ++bj) { const f32x4 v0 = acc[ai][bj][m][0], v1 = acc[ai][bj][m][1];
                    u32x4 w; w.x = cvt_pk_bf16(v0[0], v0[1]); w.y = cvt_pk_bf16(v0[2], v0[3]); w.z = cvt_pk_bf16(v1[0], v1[1]); w.w = cvt_pk_bf16(v1[2], v1[3]);
                    *(u32x4*)(rowp + bj * HALF) = w; } }
    }
};
struct EpiGate {
    static constexpr bool PERM = true, AFTER_DRAIN = false;
    bf16_t* O; int ldc; const float* bias;
    __device__ __forceinline__ void operator()(const f32x4 (&acc)[2][2][4][2], const Unit& u, int wr, int wc, int fr, int fq) const {
        const int row0 = u.pm * BM + wr * 64 + fr, col0 = u.pn * BM + wc * 32 + 8 * fq;
        f32x4 bv[2][2];
#pragma unroll
        for (int bj = 0; bj < 2; ++bj)
#pragma unroll
            for (int n = 0; n < 2; ++n) bv[bj][n] = *(const f32x4*)(bias + col0 + bj * HALF + 4 * n);
#pragma unroll
        for (int ai = 0; ai < 2; ++ai)
#pragma unroll
            for (int m = 0; m < 4; ++m) { bf16_t* rowp = O + (size_t)(row0 + ai * HALF + m * 16) * ldc + col0;
#pragma unroll
                for (int bj = 0; bj < 2; ++bj) { f32x4 v0 = acc[ai][bj][m][0] + bv[bj][0], v1 = acc[ai][bj][m][1] + bv[bj][1];
#pragma unroll
                    for (int i = 0; i < 4; ++i) { v0[i] = sigmoid_f(v0[i]); v1[i] = sigmoid_f(v1[i]); }
                    u32x4 w; w.x = cvt_pk_bf16(v0[0], v0[1]); w.y = cvt_pk_bf16(v0[2], v0[3]); w.z = cvt_pk_bf16(v1[0], v1[1]); w.w = cvt_pk_bf16(v1[2], v1[3]);
                    *(u32x4*)(rowp + bj * HALF) = w; } }
    }
};
struct EpiMerge {
    static constexpr bool PERM = false, AFTER_DRAIN = false;
    const bf16_t* gates; float* mrg; bf16_t* merged; int br;
    __device__ __forceinline__ void operator()(const f32x4 (&acc)[2][2][4][2], const Unit& u, int wr, int wc, int fr, int fq) const {
        typedef unsigned u32x2v __attribute__((ext_vector_type(2)));
        const int row0 = u.pm * BM + wr * 64 + fr, col0 = u.pn * BM + wc * 32 + 4 * fq;
#pragma unroll
        for (int ai = 0; ai < 2; ++ai)
#pragma unroll
            for (int m = 0; m < 4; ++m) { const size_t r = (size_t)(row0 + ai * HALF + m * 16);
#pragma unroll
                for (int bj = 0; bj < 2; ++bj)
#pragma unroll
                    for (int n = 0; n < 2; ++n) { const int c = col0 + bj * HALF + n * 16;
                        const u32x2v gw = *(const u32x2v*)(gates + r * 3072 + br * 1024 + c);
                        f32x4 v = acc[ai][bj][m][n]; v[0] *= bflo(gw.x); v[1] *= bfhi(gw.x); v[2] *= bflo(gw.y); v[3] *= bfhi(gw.y);
                        float* mp = mrg + r * 1024 + c;
                        if (br == 0) { *(f32x4*)mp = v; }
                        else if (br == 1) { *(f32x4*)mp = *(const f32x4*)mp + v; }
                        else { v = v + *(const f32x4*)mp; u32x2v w; w.x = cvt_pk_bf16(v[0], v[1]); w.y = cvt_pk_bf16(v[2], v[3]); *(u32x2v*)(merged + r * 1024 + c) = w; } }
                asm volatile("" ::: "memory"); }
    }
};
struct EpiResid {
    static constexpr bool PERM = false, AFTER_DRAIN = false;
    const float* base; float* out; int ldc; float alpha;
    __device__ __forceinline__ void operator()(const f32x4 (&acc)[2][2][4][2], const Unit& u, int wr, int wc, int fr, int fq) const {
        const int row0 = u.pm * BM + wr * 64 + fr, col0 = u.pn * BM + wc * 32 + 4 * fq;
#pragma unroll
        for (int ai = 0; ai < 2; ++ai)
#pragma unroll
            for (int m = 0; m < 4; ++m) { const size_t off = (size_t)(row0 + ai * HALF + m * 16) * ldc + col0;
#pragma unroll
                for (int bj = 0; bj < 2; ++bj)
#pragma unroll
                    for (int n = 0; n < 2; ++n) { const f32x4 bs = *(const f32x4*)(base + off + bj * HALF + n * 16); *(f32x4*)(out + off + bj * HALF + n * 16) = bs * alpha + acc[ai][bj][m][n]; }
                asm volatile("" ::: "memory"); }
    }
};
struct EpiUp {
    static constexpr bool PERM = true, AFTER_DRAIN = false;
    bf16_t* Ap; bf16_t* Bp; int ldc;
    __device__ __forceinline__ void operator()(const f32x4 (&acc)[2][2][4][2], const Unit& u, int wr, int wc, int fr, int fq) const {
        const int row0 = u.pm * BM + wr * 64 + fr, col0 = u.pn * HALF + wc * 32 + 8 * fq;
#pragma unroll
        for (int ai = 0; ai < 2; ++ai)
#pragma unroll
            for (int m = 0; m < 4; ++m) { const size_t off = (size_t)(row0 + ai * HALF + m * 16) * ldc + col0;
#pragma unroll
                for (int bj = 0; bj < 2; ++bj) { const f32x4 v0 = acc[ai][bj][m][0], v1 = acc[ai][bj][m][1];
                    u32x4 w; w.x = cvt_pk_bf16(v0[0], v0[1]); w.y = cvt_pk_bf16(v0[2], v0[3]); w.z = cvt_pk_bf16(v1[0], v1[1]); w.w = cvt_pk_bf16(v1[2], v1[3]);
                    *(u32x4*)((bj == 0 ? Ap : Bp) + off) = w; } }
    }
};

template <class Epi, class Sched, bool ALIGN_EPI = false, bool SP2 = false>
__device__ __forceinline__ void gemm_phase(PG8_LAS unsigned char* lds, const Gemm g, const Sched& S, const Epi& E) {
    const int tid = threadIdx.x, wid = __builtin_amdgcn_readfirstlane(tid >> 6), lane = tid & 63, wr = wid >> 2, wc = wid & 3, fr = lane & 15, fq = lane >> 4;
    const int K = g.K, nt = K / BK;
    unsigned voffA[2], voffB[2];
#pragma unroll
    for (int i = 0; i < 2; ++i) { int R, C; stage_rc(tid * 16 + i * 8192, R, C); const int Rb = Epi::PERM ? ((R & ~31) + perm32(R & 31)) : R;
        voffA[i] = (unsigned)(R * K + C) * 2u; voffB[i] = (unsigned)(Rb * K + C) * 2u; }
    const size_t kstep = (size_t)(BK * 2);
    const size_t hstep = (size_t)HALF * K * 2;
    const size_t tstep = 2 * hstep;
    const unsigned ldsw = (unsigned)wid * 1024u;
    const int aoff = lds_byte(wr * 64 + fr, fq * 8), boff = lds_byte(wc * 32 + fr, fq * 8);
#define PG8_SA(b, h) (((b) * 2 + (h)) * HTB)
#define PG8_SB(b, h) ((4 + (b) * 2 + (h)) * HTB)
#define PG8_STAGE(bufoff, gbase, voff) do { _Pragma("unroll") for (int _i = 0; _i < 2; ++_i) \
        __builtin_amdgcn_global_load_lds((const unsigned*)((const char*)(gbase) + (voff)[_i]), (PG8_LAS unsigned*)(lds + (bufoff) + ldsw + _i * 8192), 16, 0, 0); } while (0)
#define PG8_LDA(dst, b, h) do { _Pragma("unroll") for (int m = 0; m < 4; ++m) _Pragma("unroll") for (int k = 0; k < 2; ++k) dst[m][k] = *(const PG8_LAS bf16x8*)(lds + PG8_SA(b, h) + aoff + m * 2048 + k * 1024); } while (0)
#define PG8_LDB(dst, b, h) do { _Pragma("unroll") for (int n = 0; n < 2; ++n) _Pragma("unroll") for (int k = 0; k < 2; ++k) dst[n][k] = *(const PG8_LAS bf16x8*)(lds + PG8_SB(b, h) + boff + n * 2048 + k * 1024); } while (0)
#define PG8_MMA(ai, bj, At, Bt) do { __builtin_amdgcn_s_setprio(1); _Pragma("unroll") for (int m = 0; m < 4; ++m) _Pragma("unroll") for (int n = 0; n < 2; ++n) _Pragma("unroll") for (int k = 0; k < 2; ++k) \
        acc[ai][bj][m][n] = __builtin_amdgcn_mfma_f32_16x16x32_bf16(Bt[n][k], At[m][k], acc[ai][bj][m][n], 0, 0, 0); __builtin_amdgcn_s_setprio(0); } while (0)
#define PG8_WAIT_V(n) asm volatile("s_waitcnt vmcnt(" #n ")" ::: "memory")
#define PG8_WAIT_L(n) asm volatile("s_waitcnt lgkmcnt(" #n ")" ::: "memory")
#define PG8_BAR __builtin_amdgcn_s_barrier()
#define PG8_SCHED __builtin_amdgcn_sched_barrier(0)
    Unit cur, nxt; int ui = 0;
    if (!S.next(0, cur)) return;
    f32x4 acc[2][2][4][2];
#pragma unroll
    for (int a = 0; a < 2; ++a)
#pragma unroll
        for (int b = 0; b < 2; ++b)
#pragma unroll
            for (int m = 0; m < 4; ++m)
#pragma unroll
                for (int n = 0; n < 2; ++n) acc[a][b][m][n] = (f32x4){0.f, 0.f, 0.f, 0.f};
    bf16x8 At[4][2], B0[2][2], B1[2][2];
    const char* cA = (const char*)g.A + (size_t)cur.pm * tstep; const char* cB = (const char*)g.Bt + (size_t)cur.pn * tstep;
    S.a_ready(cur);
    if constexpr (SP2) {
        PG8_STAGE(PG8_SB(0, 0), cB, voffB); PG8_STAGE(PG8_SB(0, 1), cB + hstep, voffB); PG8_STAGE(PG8_SA(0, 0), cA, voffA); PG8_STAGE(PG8_SA(0, 1), cA + hstep, voffA);
        if (wr == 1) PG8_BAR;
        PG8_WAIT_V(2); PG8_BAR;
        PG8_STAGE(PG8_SB(1, 0), cB + kstep, voffB); PG8_STAGE(PG8_SA(1, 0), cA + kstep, voffA); PG8_STAGE(PG8_SB(1, 1), cB + hstep + kstep, voffB);
        PG8_WAIT_V(6); PG8_BAR;
    } else {
        PG8_STAGE(PG8_SB(0, 0), cB, voffB); PG8_STAGE(PG8_SA(0, 0), cA, voffA); PG8_STAGE(PG8_SB(0, 1), cB + hstep, voffB); PG8_STAGE(PG8_SA(0, 1), cA + hstep, voffA);
        if (wr == 1) PG8_BAR;
        PG8_WAIT_V(4); PG8_BAR;
        PG8_STAGE(PG8_SB(1, 0), cB + kstep, voffB); PG8_STAGE(PG8_SA(1, 0), cA + kstep, voffA); PG8_STAGE(PG8_SB(1, 1), cB + hstep + kstep, voffB);
        PG8_WAIT_V(6); PG8_BAR;
    }
    for (;;) {
        const bool has_next = S.next(ui + 1, nxt);
        const char* nA = has_next ? (const char*)g.A + (size_t)nxt.pm * tstep : cA; const char* nB = has_next ? (const char*)g.Bt + (size_t)nxt.pn * tstep : cB;
        for (int t = 0; t < nt; t += 2) {
            const bool last = (t == nt - 2);
            const char* a1 = cA + (size_t)(t + 1) * kstep;
            const char* a2 = last ? nA : cA + (size_t)(t + 2) * kstep; const char* b2 = last ? nB : cB + (size_t)(t + 2) * kstep;
            const char* a3 = a2 + kstep; const char* b3 = b2 + kstep;
            if (last && has_next) S.a_ready(nxt);
            if constexpr (SP2) {
            PG8_LDB(B0, 0, 0); PG8_LDB(B1, 0, 1); PG8_SCHED; PG8_LDA(At, 0, 0); PG8_STAGE(PG8_SA(1, 1), a1 + hstep, voffA);
            PG8_WAIT_V(8); PG8_WAIT_L(0); PG8_BAR; PG8_MMA(0, 0, At, B0); PG8_MMA(0, 1, At, B1); PG8_BAR; PG8_SCHED;
            PG8_LDA(At, 0, 1); PG8_STAGE(PG8_SB(0, 0), b2, voffB); PG8_STAGE(PG8_SB(0, 1), b2 + hstep, voffB); PG8_STAGE(PG8_SA(0, 0), a2, voffA);
            PG8_WAIT_V(8); PG8_WAIT_L(0); PG8_BAR; PG8_MMA(1, 0, At, B0); PG8_MMA(1, 1, At, B1); PG8_BAR; PG8_SCHED;
            PG8_LDB(B0, 1, 0); PG8_LDB(B1, 1, 1); PG8_SCHED; PG8_LDA(At, 1, 0); PG8_STAGE(PG8_SA(0, 1), a2 + hstep, voffA);
            PG8_WAIT_V(8); PG8_WAIT_L(0); PG8_BAR; PG8_MMA(0, 0, At, B0); PG8_MMA(0, 1, At, B1); PG8_BAR; PG8_SCHED;
            PG8_LDA(At, 1, 1); PG8_STAGE(PG8_SB(1, 0), b3, voffB); PG8_STAGE(PG8_SB(1, 1), b3 + hstep, voffB); PG8_STAGE(PG8_SA(1, 0), a3, voffA);
            PG8_WAIT_V(8); PG8_WAIT_L(0); PG8_BAR; PG8_MMA(1, 0, At, B0); PG8_MMA(1, 1, At, B1); PG8_BAR; PG8_SCHED;
            } else {
            PG8_LDB(B0, 0, 0); PG8_SCHED; PG8_LDA(At, 0, 0); PG8_STAGE(PG8_SA(1, 1), a1 + hstep, voffA);
            PG8_WAIT_L(8); PG8_BAR; PG8_WAIT_L(0); PG8_MMA(0, 0, At, B0); PG8_BAR; PG8_SCHED;
            PG8_LDB(B1, 0, 1); PG8_STAGE(PG8_SB(0, 0), b2, voffB);
            PG8_BAR; PG8_WAIT_L(0); PG8_MMA(0, 1, At, B1); PG8_BAR;
            PG8_LDA(At, 0, 1); PG8_STAGE(PG8_SA(0, 0), a2, voffA);
            PG8_BAR; PG8_WAIT_L(0); PG8_MMA(1, 0, At, B0); PG8_BAR; PG8_SCHED;
            PG8_STAGE(PG8_SB(0, 1), b2 + hstep, voffB);
            PG8_WAIT_V(6); PG8_BAR; PG8_MMA(1, 1, At, B1); PG8_BAR;
            PG8_LDB(B0, 1, 0); PG8_SCHED; PG8_LDA(At, 1, 0); PG8_STAGE(PG8_SA(0, 1), a2 + hstep, voffA);
            PG8_WAIT_L(8); PG8_BAR; PG8_WAIT_L(0); PG8_MMA(0, 0, At, B0); PG8_BAR; PG8_SCHED;
            PG8_LDB(B1, 1, 1); PG8_STAGE(PG8_SB(1, 0), b3, voffB);
            PG8_BAR; PG8_WAIT_L(0); PG8_MMA(0, 1, At, B1); PG8_BAR;
            PG8_LDA(At, 1, 1); PG8_STAGE(PG8_SA(1, 0), a3, voffA);
            PG8_BAR; PG8_WAIT_L(0); PG8_MMA(1, 0, At, B0); PG8_BAR; PG8_SCHED;
            PG8_STAGE(PG8_SB(1, 1), b3 + hstep, voffB);
            PG8_WAIT_V(6); PG8_BAR; PG8_MMA(1, 1, At, B1); PG8_BAR;
            }
        }
        if constexpr (ALIGN_EPI) { if (wr == 0) PG8_BAR; }
        if constexpr (!Epi::AFTER_DRAIN) { E(acc, cur, wr, wc, fr, fq); S.done(cur); }
        if (!has_next) break;
#pragma unroll
        for (int a = 0; a < 2; ++a)
#pragma unroll
            for (int b = 0; b < 2; ++b)
#pragma unroll
                for (int m = 0; m < 4; ++m)
#pragma unroll
                    for (int n = 0; n < 2; ++n) acc[a][b][m][n] = (f32x4){0.f, 0.f, 0.f, 0.f};
        cur = nxt; cA = nA; cB = nB; ++ui;
        if constexpr (ALIGN_EPI) { if (wr == 1) PG8_BAR; }
    }
    PG8_WAIT_V(0);
    if constexpr (!ALIGN_EPI) { if (wr == 0) PG8_BAR; }
    PG8_BAR;
    if constexpr (Epi::AFTER_DRAIN) { E.fused(acc, cur, wr, wc, fr, fq, lds, wid, lane); S.done(cur); }
#undef PG8_SA
#undef PG8_SB
#undef PG8_STAGE
#undef PG8_LDA
#undef PG8_LDB
#undef PG8_MMA
#undef PG8_WAIT_V
#undef PG8_WAIT_L
#undef PG8_BAR
#undef PG8_SCHED
}
}
#define GAS __attribute__((address_space(1)))
#define LAS __attribute__((address_space(3)))
typedef unsigned short bf16;
typedef unsigned v4u __attribute__((ext_vector_type(4)));
typedef float f32x4 __attribute__((ext_vector_type(4)));
typedef short bf16x8 __attribute__((ext_vector_type(8)));
typedef GAS unsigned gu32;
typedef GAS unsigned long long gu64;
#define RLX_AGENT __ATOMIC_RELAXED, __HIP_MEMORY_SCOPE_AGENT
#define LDS_WAIT() asm volatile("s_waitcnt lgkmcnt(0)" ::: "memory")
#define VM_WAIT() asm volatile("s_waitcnt vmcnt(0)" ::: "memory")
__device__ __forceinline__ unsigned long long rt() { return __builtin_amdgcn_s_memrealtime(); }
__device__ __forceinline__ unsigned f2bf(float f) { unsigned u = __builtin_bit_cast(unsigned, f); return (u + 0x7fffu + ((u >> 16) & 1u)) >> 16; }
__device__ __forceinline__ unsigned pk2(float lo, float hi) { return f2bf(lo) | (f2bf(hi) << 16); }

#define XB_TMO      128
#define XB_XCNT(j)  (256  + 64 * (j))
#define XB_XSUB(j)  (1280 + 64 * (j))
#define XB_XGEN(j)  (2304 + 64 * (j))
#define XB_TOP      3328
#define XB_TOPGEN   3392
#define XCD_BAR_WORDS 3456
#define XB_SPIN_CAP (1u << 18)

__device__ __forceinline__ unsigned xb_ld(unsigned* p)              { return __hip_atomic_load(p, __ATOMIC_RELAXED, __HIP_MEMORY_SCOPE_AGENT); }
__device__ __forceinline__ unsigned xb_add(unsigned* p, unsigned v) { return __hip_atomic_fetch_add(p, v, __ATOMIC_RELAXED, __HIP_MEMORY_SCOPE_AGENT); }
__device__ __forceinline__ unsigned xb_xcc_id() { return (unsigned)__builtin_amdgcn_s_getreg((3 << 11) | 20) & 0xFu; }
#define XB_SPIN(cond, bar) do { unsigned _sp = 0; while (cond) { __builtin_amdgcn_s_sleep(1); \
    if ((++_sp & 255u) == 0u) { if (xb_ld(&(bar)[XB_TMO])) break; if (_sp > XB_SPIN_CAP) { atomicAdd(&(bar)[XB_TMO], 1u); break; } } } } while (0)

struct XcdBarrier {
    unsigned* bar; unsigned x;
    volatile LAS unsigned* st;
};

__device__ __forceinline__ XcdBarrier xcd_barrier_post(unsigned* bar, volatile LAS unsigned* st) {
    XcdBarrier b; b.bar = bar; b.x = xb_xcc_id(); b.st = st;
    if (threadIdx.x == 0) (void)xb_add(&bar[XB_XCNT(b.x)], 1u);
    return b;
}
__device__ __forceinline__ void xcd_barrier_complete(unsigned* bar, unsigned x, unsigned& nloc, unsigned& nx) {
    const unsigned G = gridDim.x * gridDim.y * gridDim.z;
    unsigned sum, cnt, mine, sp = 0u;
    for (;;) {
        sum = 0u; cnt = 0u; mine = 0u;
#pragma unroll
        for (unsigned j = 0; j < 16; ++j) { const unsigned c = xb_ld(&bar[XB_XCNT(j)]); sum += c; cnt += (c > 0u) ? 1u : 0u; mine = (j == x) ? c : mine; }
        if (sum == G) break;
        __builtin_amdgcn_s_sleep(1);
        if ((++sp & 255u) == 0u) { if (xb_ld(&bar[XB_TMO])) break; if (sp > XB_SPIN_CAP) { atomicAdd(&bar[XB_TMO], 1u); break; } }
    }
    nloc = mine > 0u ? mine : 1u; nx = cnt > 0u ? cnt : 1u;
}

__device__ __forceinline__ void xcd_barrier(const XcdBarrier& b) {
    asm volatile("s_waitcnt vmcnt(0)" ::: "memory");
    __syncthreads();
    if (threadIdx.x == 0) {
        unsigned* bar = b.bar;
        __builtin_amdgcn_s_waitcnt(0);
        unsigned nloc = b.st[0], nx = b.st[1];
        if (nloc == 0u) { xcd_barrier_complete(bar, b.x, nloc, nx); b.st[0] = nloc; b.st[1] = nx; }
        const unsigned old = xb_add(&bar[XB_XSUB(b.x)], 1u);
        const unsigned gen = old / nloc;
        if (old + 1u == (gen + 1u) * nloc) {
            __builtin_amdgcn_fence(__ATOMIC_RELEASE, "agent");
            asm volatile("s_waitcnt vmcnt(0)" ::: "memory");
            const unsigned og = xb_add(&bar[XB_TOP], 1u);
            const unsigned tg = og / nx;
            if (og + 1u == (tg + 1u) * nx) xb_add(&bar[XB_TOPGEN], 1u);
            else XB_SPIN(xb_ld(&bar[XB_TOPGEN]) == tg, bar);
            __builtin_amdgcn_fence(__ATOMIC_ACQUIRE, "agent");
            xb_add(&bar[XB_XGEN(b.x)], 1u);
            asm volatile("s_waitcnt vmcnt(0)" ::: "memory");
        } else {
            XB_SPIN(xb_ld(&bar[XB_XGEN(b.x)]) == gen, bar);
            __builtin_amdgcn_fence(__ATOMIC_ACQUIRE, "agent");
            asm volatile("s_waitcnt vmcnt(0)" ::: "memory");
        }
    }
    __syncthreads();
}

constexpr int NWAVES = 8;
#ifndef MK_N_LAUNCHES
#define MK_N_LAUNCHES 1
#endif
constexpr int N_PHASES = 11;
constexpr int N_LAUNCHES = MK_N_LAUNCHES;

constexpr int BATCH = 8, SEQ = 4096, D = 1024, M = BATCH * SEQ;
constexpr int ATTN_W = 768, QKV_W = 3 * ATTN_W, SG_W = 512, MEM_LEN = 256, MEM_W = 256, IN_W = 3584, GATE_W = 3072, DFF = 2816, UP_W = 2 * DFF;
constexpr float LN_EPS = 1e-5f;
constexpr float ALPHA = 1.189207115002721f;

constexpr size_t MiB = 1u << 20;
constexpr size_t WS_CTL = 0, CTL_ZERO_BYTES = 1 * MiB;
constexpr size_t WS_BT = 1 * MiB;
constexpr size_t WS_WIN = 2 * MiB, WS_WG = 9 * MiB, WS_WMKV = 15 * MiB, WS_WA = 16 * MiB, WS_WB = WS_WA + MiB / 2, WS_WC = WS_WB + MiB, WS_WOUT = 18 * MiB, WS_WUP = 20 * MiB, WS_WDN = 31 * MiB;
constexpr size_t WS_KVM = 37 * MiB;
constexpr size_t WS_MEMB = 39 * MiB;
constexpr size_t WS_XB = 44 * MiB;
constexpr size_t WS_HB = WS_XB;
constexpr size_t WS_QKVA = 108 * MiB, WS_ZB = 252 * MiB, WS_QC = 316 * MiB;
constexpr size_t WS_OA = 332 * MiB, WS_OB = 348 * MiB, WS_OC = 380 * MiB;
constexpr size_t WS_MERGED = 396 * MiB;
constexpr size_t WS_GATES = 108 * MiB;
constexpr size_t WS_AP = 108 * MiB, WS_BP = 284 * MiB;
constexpr size_t WS_END = 460 * MiB;
static_assert(WS_WDN + (size_t)D * DFF * 2 <= WS_KVM && WS_GATES + (size_t)M * GATE_W * 2 <= WS_QC && WS_BP + (size_t)M * DFF * 2 <= WS_END && WS_AP + (size_t)M * DFF * 2 <= WS_BP, "d_ws map");
constexpr int CW_TMO = 0, CW_CODE = 1;
constexpr int CW_BAR = 4096;
constexpr int CW_SEAM = 16384, SEAM_BANK = 128 * 64;

constexpr int RING_OFF = 0, RING_BYTES = 131072;
constexpr int LDSCTL_OFF = RING_BYTES, MISC_OFF = LDSCTL_OFF + 320;
constexpr int LDS_BYTES = 147456;

struct Frame {
    LAS unsigned char* lds;
    volatile LAS unsigned* MISC;
    gu32* ctl;
    int tid, lane, wave;
    int vcu, G;
    const float* in[23];
    float* out;
    unsigned char* ws;
};
__device__ __forceinline__ float wave_sum(float v) {
#pragma unroll
    for (int o = 1; o < 64; o <<= 1) v += __shfl_xor(v, o);
    return v;
}
__device__ __forceinline__ float bf2f(bf16 h) { return __uint_as_float((unsigned)h << 16); }
__device__ __forceinline__ float bflo_(unsigned u) { return __uint_as_float(u << 16); }
__device__ __forceinline__ float bfhi_(unsigned u) { return __uint_as_float(u & 0xffff0000u); }
__device__ __forceinline__ void unpack8(const v4u w, float (&f)[8]) { f[0] = bflo_(w.x); f[1] = bfhi_(w.x); f[2] = bflo_(w.y); f[3] = bfhi_(w.y); f[4] = bflo_(w.z); f[5] = bfhi_(w.z); f[6] = bflo_(w.w); f[7] = bfhi_(w.w); }
__device__ __forceinline__ float gelu_tanh(float x) { const float u2 = 1.5957691216057308f * x * (1.0f + 0.044715f * x * x); return x * __builtin_amdgcn_rcpf(1.0f + __expf(-u2)); }

__device__ __forceinline__ void p0_transpose_item(const float* W, int K, int N, bf16* WT, int ldt, int koff, int mode, LAS float* scr, int item, int lane) {
    const int nblk = N / 32, kb = item / nblk, nb = item % nblk, k0 = 64 * kb, n0 = 32 * nb;
#pragma unroll 8
    for (int i = 0; i < 32; ++i) { const int kk = 2 * i + (lane >> 5); scr[kk * 33 + (lane & 31)] = W[(size_t)(k0 + kk) * N + n0 + (lane & 31)]; }
    LDS_WAIT(); asm volatile("" ::: "memory");
    int r0 = n0;
    if (mode == 1) { r0 = (n0 < DFF) ? (256 * (n0 / 128) + (n0 % 128)) : (256 * ((n0 - DFF) / 128) + 128 + ((n0 - DFF) % 128)); }
    const int c = lane & 7;
#pragma unroll
    for (int j = 0; j < 4; ++j) { const int n = (lane >> 3) + 8 * j; const LAS float* s = scr + (8 * c) * 33 + n;
        v4u o; o.x = pk2(s[0 * 33], s[1 * 33]); o.y = pk2(s[2 * 33], s[3 * 33]); o.z = pk2(s[4 * 33], s[5 * 33]); o.w = pk2(s[6 * 33], s[7 * 33]);
        *(GAS v4u*)(WT + (size_t)(r0 + n) * ldt + koff + k0 + 8 * c) = o; }
    LDS_WAIT(); asm volatile("" ::: "memory");
}
__device__ __forceinline__ void cvt_rows_bf16(Frame& F, const float* src, bf16* dst, size_t n8) {
    const size_t gid = (size_t)F.vcu * 512 + F.tid, NT = (size_t)F.G * 512;
    for (size_t i = gid; i < n8; i += NT) { const f32x4 a = *(const GAS f32x4*)(src + i * 8), b = *(const GAS f32x4*)(src + i * 8 + 4);
        v4u o; o.x = pk2(a.x, a.y); o.y = pk2(a.z, a.w); o.z = pk2(b.x, b.y); o.w = pk2(b.z, b.w); *(GAS v4u*)(dst + i * 8) = o; }
}
__device__ __forceinline__ int t5_bucket(int dist) {
    if (dist < 16) return dist;
    int large = 16 + (int)(log((double)dist / 16.0) / log(128.0) * 16.0);
    return large < 31 ? large : 31;
}
__device__ __forceinline__ void p0_prologue(Frame& F) {
    LAS float* scr = (LAS float*)(F.lds + RING_OFF + F.wave * 16384);
    const int gw = F.vcu * NWAVES + F.wave, NGW = F.G * NWAVES;
    unsigned char* ws = F.ws;
    constexpr int I_IN = (D / 64) * (IN_W / 32), I_G = (D / 64) * (GATE_W / 32), I_MKV = (D / 64) * (512 / 32), I_A = (256 / 64) * (D / 32), I_B = (512 / 64) * (D / 32), I_C = I_A,
                  I_OUT = (D / 64) * (D / 32), I_UP = (D / 64) * (UP_W / 32), I_DN = (DFF / 64) * (D / 32);
    constexpr int NITEMS = I_IN + I_G + I_MKV + I_A + I_B + I_C + I_OUT + I_UP + I_DN;
    for (int it = gw; it < NITEMS; it += NGW) {
        int r = it;
        if (r < I_IN) { p0_transpose_item(F.in[3], D, IN_W, (bf16*)(ws + WS_WIN), D, 0, 0, scr, r, F.lane); continue; } r -= I_IN;
        if (r < I_G) { p0_transpose_item(F.in[12], D, GATE_W, (bf16*)(ws + WS_WG), D, 0, 0, scr, r, F.lane); continue; } r -= I_G;
        if (r < I_MKV) { p0_transpose_item(F.in[4], D, 512, (bf16*)(ws + WS_WMKV), D, 0, 0, scr, r, F.lane); continue; } r -= I_MKV;
        if (r < I_A) { p0_transpose_item(F.in[9], 256, D, (bf16*)(ws + WS_WA), 256, 0, 0, scr, r, F.lane); continue; } r -= I_A;
        if (r < I_B) { p0_transpose_item(F.in[10], 512, D, (bf16*)(ws + WS_WB), 512, 0, 0, scr, r, F.lane); continue; } r -= I_B;
        if (r < I_C) { p0_transpose_item(F.in[11], 256, D, (bf16*)(ws + WS_WC), 256, 0, 0, scr, r, F.lane); continue; } r -= I_C;
        if (r < I_OUT) { p0_transpose_item(F.in[14], D, D, (bf16*)(ws + WS_WOUT), D, 0, 0, scr, r, F.lane); continue; } r -= I_OUT;
        if (r < I_UP) { p0_transpose_item(F.in[17], D, UP_W, (bf16*)(ws + WS_WUP), D, 0, 1, scr, r, F.lane); continue; } r -= I_UP;
        p0_transpose_item(F.in[20], DFF, D, (bf16*)(ws + WS_WDN), DFF, 0, 0, scr, r, F.lane);
    }
    cvt_rows_bf16(F, F.in[0], (bf16*)(ws + WS_XB), (size_t)M * D / 8);
    cvt_rows_bf16(F, F.in[1], (bf16*)(ws + WS_MEMB), (size_t)BATCH * MEM_LEN * D / 8);
    if (blockIdx.x == 0) { float* BT = (float*)(ws + WS_BT); const float* rb = F.in[2];
        for (int i = F.tid; i < 12 * 129; i += 512) { const int gh = i / 129, j = i % 129, g = gh >> 2, dil = g == 0 ? 1 : (g == 1 ? 4 : 16);
            BT[gh * 132 + j] = rb[t5_bucket(j * dil) * 12 + gh]; } }
}

__device__ __forceinline__ void p2_attn_simple(Frame& F) {
    const bf16* QKVA = (const bf16*)(F.ws + WS_QKVA); const float* BT = (const float*)(F.ws + WS_BT); bf16* OA = (bf16*)(F.ws + WS_OA);
    const int gid = F.vcu * 512 + F.tid, NT = F.G * 512;
    for (int it = gid; it < 4 * M; it += NT) {
        const int h = it / M, m = it % M, t = m % SEQ;
        float mx = -1e30f, l = 0.f; float o[64];
#pragma unroll
        for (int e = 0; e < 64; ++e) o[e] = 0.f;
        for (int g = 0; g < 3; ++g) {
            const int dil = g == 0 ? 1 : (g == 1 ? 4 : 16);
            const bf16* qp = QKVA + (size_t)m * QKV_W + g * 256 + h * 64;
            float q[64];
#pragma unroll
            for (int c = 0; c < 8; ++c) { float f[8]; unpack8(*(const GAS v4u*)(qp + c * 8), f);
#pragma unroll
                for (int i = 0; i < 8; ++i) q[c * 8 + i] = f[i]; }
            const float* bt = BT + (g * 4 + h) * 132;
            const int jmax = (t / dil) < 128 ? (t / dil) : 128;
            for (int j = 0; j <= jmax; ++j) {
                const bf16* kp = QKVA + (size_t)(m - j * dil) * QKV_W + ATTN_W + g * 256 + h * 64;
                float s = 0.f;
#pragma unroll
                for (int c = 0; c < 8; ++c) { float f[8]; unpack8(*(const GAS v4u*)(kp + c * 8), f);
#pragma unroll
                    for (int i = 0; i < 8; ++i) s += q[c * 8 + i] * f[i]; }
                s += bt[j];
                if (s > mx) { const float fs = __expf(mx - s); l *= fs;
#pragma unroll
                    for (int e = 0; e < 64; ++e) o[e] *= fs;
                    mx = s; }
                const float p = __expf(s - mx); l += p;
                const bf16* vp = kp + ATTN_W;
#pragma unroll
                for (int c = 0; c < 8; ++c) { float f[8]; unpack8(*(const GAS v4u*)(vp + c * 8), f);
#pragma unroll
                    for (int i = 0; i < 8; ++i) o[c * 8 + i] += p * f[i]; }
            }
        }
        const float rl = 1.0f / l; bf16* op = OA + (size_t)m * 256 + h * 64;
#pragma unroll
        for (int c = 0; c < 8; ++c) { v4u w; w.x = pk2(o[c * 8] * rl, o[c * 8 + 1] * rl); w.y = pk2(o[c * 8 + 2] * rl, o[c * 8 + 3] * rl); w.z = pk2(o[c * 8 + 4] * rl, o[c * 8 + 5] * rl); w.w = pk2(o[c * 8 + 6] * rl, o[c * 8 + 7] * rl);
            *(GAS v4u*)(op + c * 8) = w; }
    }
}
__device__ __forceinline__ void p2_cross_simple(Frame& F) {
    const bf16* QC = (const bf16*)(F.ws + WS_QC); const bf16* KVM = (const bf16*)(F.ws + WS_KVM); bf16* OC = (bf16*)(F.ws + WS_OC);
    const int gid = F.vcu * 512 + F.tid, NT = F.G * 512;
    for (int it = gid; it < 4 * M; it += NT) {
        const int h = it / M, m = it % M, b = m / SEQ;
        float mx = -1e30f, l = 0.f; float o[64], q[64];
#pragma unroll
        for (int e = 0; e < 64; ++e) o[e] = 0.f;
        const bf16* qp = QC + (size_t)m * 256 + h * 64;
#pragma unroll
        for (int c = 0; c < 8; ++c) { float f[8]; unpack8(*(const GAS v4u*)(qp + c * 8), f);
#pragma unroll
            for (int i = 0; i < 8; ++i) q[c * 8 + i] = f[i]; }
        for (int j = 0; j < MEM_LEN; ++j) {
            const bf16* kp = KVM + (size_t)(b * MEM_LEN + j) * 512 + h * 64;
            float s = 0.f;
#pragma unroll
            for (int c = 0; c < 8; ++c) { float f[8]; unpack8(*(const GAS v4u*)(kp + c * 8), f);
#pragma unroll
                for (int i = 0; i < 8; ++i) s += q[c * 8 + i] * f[i]; }
            if (s > mx) { const float fs = __expf(mx - s); l *= fs;
#pragma unroll
                for (int e = 0; e < 64; ++e) o[e] *= fs;
                mx = s; }
            const float p = __expf(s - mx); l += p;
            const bf16* vp = kp + 256;
#pragma unroll
            for (int c = 0; c < 8; ++c) { float f[8]; unpack8(*(const GAS v4u*)(vp + c * 8), f);
#pragma unroll
                for (int i = 0; i < 8; ++i) o[c * 8 + i] += p * f[i]; }
        }
        const float rl = 1.0f / l; bf16* op = OC + (size_t)m * 256 + h * 64;
#pragma unroll
        for (int c = 0; c < 8; ++c) { v4u w; w.x = pk2(o[c * 8] * rl, o[c * 8 + 1] * rl); w.y = pk2(o[c * 8 + 2] * rl, o[c * 8 + 3] * rl); w.z = pk2(o[c * 8 + 4] * rl, o[c * 8 + 5] * rl); w.w = pk2(o[c * 8 + 6] * rl, o[c * 8 + 7] * rl);
            *(GAS v4u*)(op + c * 8) = w; }
    }
}
__device__ __forceinline__ void p2_spatial_simple(Frame& F) {
    const bf16* ZB = (const bf16*)(F.ws + WS_ZB); bf16* OB = (bf16*)(F.ws + WS_OB);
    LAS float* st = (LAS float*)(F.lds + RING_OFF);
    const float* lng = F.in[5]; const float* lnb = F.in[6]; const float* wsp = F.in[7]; const float* bsp = F.in[8];
    for (int item = F.vcu; item < M / 128; item += F.G) {
        const int m0 = item * 128;
        for (int i = 0; i < 16; ++i) { const int tok = F.wave * 16 + i; float f[8]; unpack8(*(const GAS v4u*)(ZB + (size_t)(m0 + tok) * 1024 + 512 + F.lane * 8), f);
            float s = 0.f;
#pragma unroll
            for (int k = 0; k < 8; ++k) s += f[k];
            const float mean = wave_sum(s) * (1.0f / 512.0f); float s2 = 0.f;
#pragma unroll
            for (int k = 0; k < 8; ++k) { const float dd = f[k] - mean; s2 += dd * dd; }
            const float rstd = 1.0f / sqrtf(wave_sum(s2) * (1.0f / 512.0f) + LN_EPS);
            if (F.lane == 0) { st[tok * 2] = mean; st[tok * 2 + 1] = rstd; } }
        __syncthreads();
        const int ch = F.tid, g = ch >> 6; const float lg = lng[ch], lb = lnb[ch];
        for (int p = 0; p < 128; ++p) {
            const float* wrow = wsp + (size_t)(g * 128 + p) * 128; float acc = 0.f;
            for (int q = 0; q <= p; ++q) { const float vv = bf2f(ZB[(size_t)(m0 + q) * 1024 + 512 + ch]); const float vn = (vv - st[2 * q]) * st[2 * q + 1] * lg + lb; acc += wrow[q] * vn; }
            const float u = bf2f(ZB[(size_t)(m0 + p) * 1024 + ch]);
            OB[(size_t)(m0 + p) * 512 + ch] = (bf16)f2bf(u * (acc + bsp[g * 128 + p]));
        }
        __syncthreads();
    }
}
__device__ __forceinline__ void ln_rows(Frame& F, const float* src, float* dst32, bf16* dstb, const float* g, const float* b) {
    const int gw = F.vcu * NWAVES + F.wave, NGW = F.G * NWAVES;
    f32x4 gv[4], bv[4];
#pragma unroll
    for (int j = 0; j < 4; ++j) { gv[j] = *((const GAS f32x4*)g + F.lane + 64 * j); bv[j] = *((const GAS f32x4*)b + F.lane + 64 * j); }
    for (int m = gw; m < M; m += NGW) {
        const GAS f32x4* xr = (const GAS f32x4*)(src + (size_t)m * D) + F.lane;
        f32x4 v[4]; float s = 0.f;
#pragma unroll
        for (int j = 0; j < 4; ++j) { v[j] = xr[64 * j]; s += (v[j].x + v[j].y) + (v[j].z + v[j].w); }
        const float mean = wave_sum(s) * (1.f / D); float s2 = 0.f;
#pragma unroll
        for (int j = 0; j < 4; ++j) { v[j] = v[j] - mean; s2 += (v[j].x * v[j].x + v[j].y * v[j].y) + (v[j].z * v[j].z + v[j].w * v[j].w); }
        const float rstd = 1.f / sqrtf(wave_sum(s2) * (1.f / D) + LN_EPS);
#pragma unroll
        for (int j = 0; j < 4; ++j) { v[j] = v[j] * rstd * gv[j] + bv[j];
            if (dst32) *((GAS f32x4*)(dst32 + (size_t)m * D) + F.lane + 64 * j) = v[j];
            if (dstb) *((GAS unsigned long long*)(dstb + (size_t)m * D) + F.lane + 64 * j) = (unsigned long long)pk2(v[j].x, v[j].y) | ((unsigned long long)pk2(v[j].z, v[j].w) << 32); }
    }
}
__device__ __forceinline__ void conv_gate_rows(Frame& F) {
    const bf16* AP = (const bf16*)(F.ws + WS_AP); bf16* BP = (bf16*)(F.ws + WS_BP); const float* cw = F.in[18]; const float* cb = F.in[19];
    const size_t gid = (size_t)F.vcu * 512 + F.tid, NT = (size_t)F.G * 512, NIT = (size_t)M * (DFF / 8);
    for (size_t idx = gid; idx < NIT; idx += NT) {
        const int m = (int)(idx / (DFF / 8)), c = (int)(idx % (DFF / 8)) * 8, t = m % SEQ;
        float a0[8], a1[8], a2[8], bb[8];
        unpack8(*(const GAS v4u*)(AP + (size_t)m * DFF + c), a0);
        if (t >= 1) unpack8(*(const GAS v4u*)(AP + (size_t)(m - 1) * DFF + c), a1); else {
#pragma unroll
            for (int i = 0; i < 8; ++i) a1[i] = 0.f; }
        if (t >= 2) unpack8(*(const GAS v4u*)(AP + (size_t)(m - 2) * DFF + c), a2); else {
#pragma unroll
            for (int i = 0; i < 8; ++i) a2[i] = 0.f; }
        unpack8(*(const GAS v4u*)(BP + (size_t)m * DFF + c), bb);
        float r[8];
#pragma unroll
        for (int i = 0; i < 8; ++i) { const float y = cw[c + i] * a2[i] + cw[DFF + c + i] * a1[i] + cw[2 * DFF + c + i] * a0[i] + cb[c + i]; r[i] = gelu_tanh(y) * bb[i]; }
        v4u w; w.x = pk2(r[0], r[1]); w.y = pk2(r[2], r[3]); w.z = pk2(r[4], r[5]); w.w = pk2(r[6], r[7]);
        *(GAS v4u*)(BP + (size_t)m * DFF + c) = w;
    }
}


#if defined(MK_DIAG)
__device__ __forceinline__ float dot_bf16(const bf16* a, const bf16* b, int K) {
    float s = 0.f;
    for (int k = 0; k < K; k += 8) { float fa[8], fb[8]; unpack8(*(const GAS v4u*)(a + k), fa); unpack8(*(const GAS v4u*)(b + k), fb);
#pragma unroll
        for (int i = 0; i < 8; ++i) s += fa[i] * fb[i]; }
    return s;
}
__device__ __forceinline__ void chk_note(Frame& F, int slot, float ratio) {
    float r = ratio;
#pragma unroll
    for (int o = 1; o < 64; o <<= 1) r = fmaxf(r, __shfl_xor(r, o));
    if (F.lane == 0 && r > 0.f) atomicMax((unsigned*)(F.ctl + 512 + 64 * slot), __float_as_uint(r));
}
__device__ __forceinline__ void chk0(Frame& F) {
    const size_t gid = (size_t)F.vcu * 512 + F.tid, NT = (size_t)F.G * 512; unsigned char* ws = F.ws; float worst = 0.f;
#define CHKW(W, Kd, Nd, WT, ldt, mode) for (size_t i = gid; i < (size_t)(Kd) * (Nd); i += NT) { const int k = (int)(i / (Nd)), n = (int)(i % (Nd)); int r = n; \
        if (mode == 1) r = (n < DFF) ? (256 * (n / 128) + n % 128) : (256 * ((n - DFF) / 128) + 128 + (n - DFF) % 128); \
        const float e = __uint_as_float(f2bf((W)[i]) << 16), a = bf2f(((const bf16*)(ws + (WT)))[(size_t)r * (ldt) + k]); worst = fmaxf(worst, fabsf(e - a) * 1e4f); }
    CHKW(F.in[3], D, IN_W, WS_WIN, D, 0) CHKW(F.in[12], D, GATE_W, WS_WG, D, 0) CHKW(F.in[4], D, 512, WS_WMKV, D, 0)
    CHKW(F.in[9], 256, D, WS_WA, 256, 0) CHKW(F.in[10], 512, D, WS_WB, 512, 0) CHKW(F.in[11], 256, D, WS_WC, 256, 0)
    CHKW(F.in[14], D, D, WS_WOUT, D, 0) CHKW(F.in[17], D, UP_W, WS_WUP, D, 1) CHKW(F.in[20], DFF, D, WS_WDN, DFF, 0)
#undef CHKW
    for (size_t i = gid; i < (size_t)M * D; i += NT) { const float e = __uint_as_float(f2bf(F.in[0][i]) << 16), a = bf2f(((const bf16*)(ws + WS_XB))[i]); worst = fmaxf(worst, fabsf(e - a) * 1e4f); }
    for (size_t i = gid; i < (size_t)BATCH * MEM_LEN * D; i += NT) { const float e = __uint_as_float(f2bf(F.in[1][i]) << 16), a = bf2f(((const bf16*)(ws + WS_MEMB))[i]); worst = fmaxf(worst, fabsf(e - a) * 1e4f); }
    chk_note(F, 0, worst);
}
__device__ __forceinline__ void chk1(Frame& F) {
    const size_t gid = (size_t)F.vcu * 512 + F.tid, NT = (size_t)F.G * 512; unsigned char* ws = F.ws; float worst = 0.f;
    const bf16* XB = (const bf16*)(ws + WS_XB); const bf16* WIN = (const bf16*)(ws + WS_WIN);
    for (size_t i = gid; i < (size_t)(M / 3) * IN_W; i += NT) { const int m = 3 * (int)(i / IN_W), n = (int)(i % IN_W);
        const float acc = dot_bf16(XB + (size_t)m * D, WIN + (size_t)n * D, D); float e, a;
        if (n < QKV_W) { e = n < ATTN_W ? acc * 0.125f : acc; a = bf2f(((const bf16*)(ws + WS_QKVA))[(size_t)m * QKV_W + n]); }
        else if (n < QKV_W + 1024) { e = gelu_tanh(acc); a = bf2f(((const bf16*)(ws + WS_ZB))[(size_t)m * 1024 + n - QKV_W]); }
        else { e = acc * 0.125f; a = bf2f(((const bf16*)(ws + WS_QC))[(size_t)m * 256 + n - QKV_W - 1024]); }
        worst = fmaxf(worst, fabsf(e - a) / (0.02f + 0.01f * fabsf(e))); }
    chk_note(F, 1, worst); worst = 0.f;
    for (size_t i = gid; i < (size_t)BATCH * MEM_LEN * 512; i += NT) { const int m = (int)(i / 512), n = (int)(i % 512);
        const float e = dot_bf16((const bf16*)(ws + WS_MEMB) + (size_t)m * D, (const bf16*)(ws + WS_WMKV) + (size_t)n * D, D), a = bf2f(((const bf16*)(ws + WS_KVM))[i]);
        worst = fmaxf(worst, fabsf(e - a) / (0.02f + 0.01f * fabsf(e))); }
    chk_note(F, 2, worst);
}
__device__ __forceinline__ void chk3a(Frame& F) {
    const size_t gid = (size_t)F.vcu * 512 + F.tid, NT = (size_t)F.G * 512; unsigned char* ws = F.ws; float worst = 0.f;
    for (size_t i = gid; i < (size_t)(M / 3) * GATE_W; i += NT) { const int m = 3 * (int)(i / GATE_W), n = (int)(i % GATE_W);
        const float acc = dot_bf16((const bf16*)(ws + WS_XB) + (size_t)m * D, (const bf16*)(ws + WS_WG) + (size_t)n * D, D) + F.in[13][n];
        const float e = 1.0f / (1.0f + expf(-acc)), a = bf2f(((const bf16*)(ws + WS_GATES))[(size_t)m * GATE_W + n]); worst = fmaxf(worst, fabsf(e - a) / 0.01f);  if (fabsf(e - a) > 0.02f) { atomicAdd((unsigned*)(F.ctl + 512 + 64 * 8), 1u); atomicMin((unsigned*)(F.ctl + 512 + 64 * 9), 0x7fffffffu - (unsigned)(i)); } }
    chk_note(F, 3, worst);
}
__device__ __forceinline__ void chk3b(Frame& F) {
    const size_t gid = (size_t)F.vcu * 512 + F.tid, NT = (size_t)F.G * 512; unsigned char* ws = F.ws; float worst = 0.f; const bf16* GT = (const bf16*)(ws + WS_GATES);
    for (size_t i = gid; i < (size_t)M * D; i += NT) { const int m = (int)(i / D), n = (int)(i % D);
        const float pa = dot_bf16((const bf16*)(ws + WS_OA) + (size_t)m * 256, (const bf16*)(ws + WS_WA) + (size_t)n * 256, 256);
        const float pb = dot_bf16((const bf16*)(ws + WS_OB) + (size_t)m * 512, (const bf16*)(ws + WS_WB) + (size_t)n * 512, 512);
        const float pc = dot_bf16((const bf16*)(ws + WS_OC) + (size_t)m * 256, (const bf16*)(ws + WS_WC) + (size_t)n * 256, 256);
        const float e = bf2f(GT[(size_t)m * GATE_W + n]) * pa + bf2f(GT[(size_t)m * GATE_W + 1024 + n]) * pb + bf2f(GT[(size_t)m * GATE_W + 2048 + n]) * pc;
        const float a = bf2f(((const bf16*)(ws + WS_MERGED))[i]); worst = fmaxf(worst, fabsf(e - a) / (0.01f + 0.01f * fabsf(e))); }
    chk_note(F, 4, worst);
}
__device__ __forceinline__ void chk4(Frame& F) {
    const size_t gid = (size_t)F.vcu * 512 + F.tid, NT = (size_t)F.G * 512; unsigned char* ws = F.ws; float worst = 0.f;
    for (size_t i = gid; i < (size_t)M * D; i += NT) { const int m = (int)(i / D), n = (int)(i % D);
        const float e = ALPHA * F.in[0][i] + dot_bf16((const bf16*)(ws + WS_MERGED) + (size_t)m * D, (const bf16*)(ws + WS_WOUT) + (size_t)n * D, D);
        worst = fmaxf(worst, fabsf(e - F.out[i]) / 1e-3f); }
    chk_note(F, 5, worst);
}
__device__ __forceinline__ void chk5(Frame& F) {
    const size_t gid = (size_t)F.vcu * 512 + F.tid, NT = (size_t)F.G * 512; unsigned char* ws = F.ws; float worst = 0.f;
    for (size_t i = gid; i < (size_t)(M / 3) * UP_W; i += NT) { const int m = 3 * (int)(i / UP_W), r = (int)(i % UP_W), pn = r >> 8, c = r & 255;
        const float e = dot_bf16((const bf16*)(ws + WS_HB) + (size_t)m * D, (const bf16*)(ws + WS_WUP) + (size_t)r * D, D);
        const float a = c < 128 ? bf2f(((const bf16*)(ws + WS_AP))[(size_t)m * DFF + pn * 128 + c]) : bf2f(((const bf16*)(ws + WS_BP))[(size_t)m * DFF + pn * 128 + c - 128]);
        worst = fmaxf(worst, fabsf(e - a) / (0.02f + 0.01f * fabsf(e))); }
    chk_note(F, 6, worst);
}
__device__ __forceinline__ void chk6(Frame& F) {
    const size_t gid = (size_t)F.vcu * 512 + F.tid, NT = (size_t)F.G * 512; unsigned char* ws = F.ws; float worst = 0.f;
    for (size_t i0 = gid; i0 < (size_t)(M / 3) * D; i0 += NT) { const int m = 3 * (int)(i0 / D), n = (int)(i0 % D); const size_t i = (size_t)m * D + n;
        const float e = ALPHA * bf2f(((const bf16*)(ws + WS_HB))[i]) + dot_bf16((const bf16*)(ws + WS_BP) + (size_t)m * DFF, (const bf16*)(ws + WS_WDN) + (size_t)n * DFF, DFF);
        worst = fmaxf(worst, fabsf(e - F.out[i]) / 0.05f); }
    chk_note(F, 7, worst);
}
__device__ __forceinline__ void chk_fin(Frame& F) {
    if (blockIdx.x == 0 && F.tid == 0) { int first = -1; float rmax = 0.f;
        for (int s = 0; s < 8; ++s) { const float r = __uint_as_float(__hip_atomic_load(F.ctl + 512 + 64 * s, RLX_AGENT)); if (r > 1.0f && first < 0) first = s; if (s == MK_DIAG_SLOT) rmax = r; }
#if MK_DIAG_SLOT == 8
        F.out[0] += 100.0f * (float)__hip_atomic_load(F.ctl + 512 + 64 * 8, RLX_AGENT);
#elif MK_DIAG_SLOT >= 0
        F.out[0] += 100.0f * rmax;
#else
        F.out[0] += 100.0f * (float)(first + 1);
#endif
    }
}
#endif

struct Args { const float* in[23]; float* out; unsigned char* ws; int ph_lo, ph_hi, li, pad; };
__global__ void __launch_bounds__(NWAVES * 64, 2) mk_fwd(Args args) {
    extern __shared__ __attribute__((aligned(16))) unsigned char lds[];
    Frame F;
    F.lds = (LAS unsigned char*)lds;
    F.MISC = (volatile LAS unsigned*)(F.lds + MISC_OFF);
    F.tid = threadIdx.x; F.lane = F.tid & 63; F.wave = __builtin_amdgcn_readfirstlane(F.tid >> 6);
    F.G = gridDim.x; { const int bx = blockIdx.x; F.vcu = (F.G % 8 == 0) ? (bx % 8) * (F.G / 8) + bx / 8 : bx; }
    unsigned char* ws = args.ws; F.ws = ws; F.out = args.out;
#pragma unroll
    for (int i = 0; i < 23; ++i) F.in[i] = args.in[i];
    F.ctl = (gu32*)(ws + WS_CTL);
    for (int u = F.tid; u < (LDS_BYTES - LDSCTL_OFF) / 4; u += NWAVES * 64) ((LAS unsigned*)(F.lds + LDSCTL_OFF))[u] = 0u;
    __syncthreads();
    XcdBarrier bar; bar.bar = (unsigned*)(F.ctl + CW_BAR); bar.x = 0; bar.st = nullptr;
    if (N_LAUNCHES == 1) bar = xcd_barrier_post((unsigned*)(F.ctl + CW_BAR), F.MISC + 8);
#define GRID_BAR() do { if (N_LAUNCHES == 1) { xcd_barrier(bar); } } while (0)
    const int lo = args.ph_lo, hi = args.ph_hi;
#define IN(k) (lo <= (k) && (k) < hi)
#define BOTH(k) (IN(k) && IN((k) + 1))
    const int G = F.G, bx = (int)blockIdx.x;
#if defined(MK_DIAG)
    if (args.pad != 0) { switch (args.pad) { case 1: chk0(F); break; case 2: chk1(F); break; case 3: chk3a(F); break; case 4: chk3b(F); break; case 5: chk4(F); break; case 6: chk5(F); break; case 7: chk6(F); break; default: chk_fin(F); break; } return; }
#endif

    if (IN(0)) { p0_prologue(F); if (BOTH(0)) GRID_BAR(); }

    if (IN(1)) {
        { pg8::Gemm g{(const bf16*)(ws + WS_XB), (const bf16*)(ws + WS_WIN), M, IN_W, D}; pg8::StaticOrder S; S.init(M, IN_W, G, bx);
          pg8::EpiProj E{(bf16*)(ws + WS_QKVA), (bf16*)(ws + WS_ZB), (bf16*)(ws + WS_QC)};
          pg8::gemm_phase<pg8::EpiProj, pg8::StaticOrder, true, true>(F.lds + RING_OFF, g, S, E); }
        { pg8::Gemm g{(const bf16*)(ws + WS_MEMB), (const bf16*)(ws + WS_WMKV), BATCH * MEM_LEN, 512, D}; pg8::StaticOrder S; S.init(BATCH * MEM_LEN, 512, G, bx);
          pg8::EpiPlain E{(bf16*)(ws + WS_KVM), 512};
          pg8::gemm_phase<pg8::EpiPlain, pg8::StaticOrder, true, true>(F.lds + RING_OFF, g, S, E); }
        if (BOTH(1)) GRID_BAR();
    }
    if (IN(2)) {
        p2_attn_simple(F); p2_cross_simple(F); p2_spatial_simple(F);
        if (BOTH(2)) GRID_BAR();
    }
    if (IN(3)) {
        pg8::Gemm g{(const bf16*)(ws + WS_XB), (const bf16*)(ws + WS_WG), M, GATE_W, D}; pg8::StaticOrder S; S.init(M, GATE_W, G, bx);
        pg8::EpiGate E{(bf16*)(ws + WS_GATES), GATE_W, F.in[13]};
        pg8::gemm_phase<pg8::EpiGate, pg8::StaticOrder, true, true>(F.lds + RING_OFF, g, S, E);
        if (BOTH(3)) GRID_BAR();
    }
    if (IN(4)) {
        { pg8::Gemm g{(const bf16*)(ws + WS_OA), (const bf16*)(ws + WS_WA), M, D, 256}; pg8::StaticOrder S; S.init(M, D, G, bx);
          pg8::EpiMerge E{(const bf16*)(ws + WS_GATES), F.out, (bf16*)(ws + WS_MERGED), 0};
          pg8::gemm_phase<pg8::EpiMerge, pg8::StaticOrder, true, true>(F.lds + RING_OFF, g, S, E); }
        { pg8::Gemm g{(const bf16*)(ws + WS_OB), (const bf16*)(ws + WS_WB), M, D, 512}; pg8::StaticOrder S; S.init(M, D, G, bx);
          pg8::EpiMerge E{(const bf16*)(ws + WS_GATES), F.out, (bf16*)(ws + WS_MERGED), 1};
          pg8::gemm_phase<pg8::EpiMerge, pg8::StaticOrder, true, true>(F.lds + RING_OFF, g, S, E); }
        { pg8::Gemm g{(const bf16*)(ws + WS_OC), (const bf16*)(ws + WS_WC), M, D, 256}; pg8::StaticOrder S; S.init(M, D, G, bx);
          pg8::EpiMerge E{(const bf16*)(ws + WS_GATES), F.out, (bf16*)(ws + WS_MERGED), 2};
          pg8::gemm_phase<pg8::EpiMerge, pg8::StaticOrder, true, true>(F.lds + RING_OFF, g, S, E); }
        if (BOTH(4)) GRID_BAR();
    }
    if (IN(5)) {
        pg8::Gemm g{(const bf16*)(ws + WS_MERGED), (const bf16*)(ws + WS_WOUT), M, D, D}; pg8::StaticOrder S; S.init(M, D, G, bx);
        pg8::EpiResid E{F.in[0], F.out, D, ALPHA};
        pg8::gemm_phase<pg8::EpiResid, pg8::StaticOrder, true, true>(F.lds + RING_OFF, g, S, E);
        if (BOTH(5)) GRID_BAR();
    }
    if (IN(6)) { ln_rows(F, F.out, F.out, (bf16*)(ws + WS_HB), F.in[15], F.in[16]); if (BOTH(6)) GRID_BAR(); }
    if (IN(7)) {
        pg8::Gemm g{(const bf16*)(ws + WS_HB), (const bf16*)(ws + WS_WUP), M, UP_W, D}; pg8::StaticOrder S; S.init(M, UP_W, G, bx);
        pg8::EpiUp E{(bf16*)(ws + WS_AP), (bf16*)(ws + WS_BP), DFF};
        pg8::gemm_phase<pg8::EpiUp, pg8::StaticOrder, true, true>(F.lds + RING_OFF, g, S, E);
        if (BOTH(7)) GRID_BAR();
    }
    if (IN(8)) { conv_gate_rows(F); if (BOTH(8)) GRID_BAR(); }
    if (IN(9)) {
        pg8::Gemm g{(const bf16*)(ws + WS_BP), (const bf16*)(ws + WS_WDN), M, D, DFF}; pg8::StaticOrder S; S.init(M, D, G, bx);
        pg8::EpiResid E{F.out, F.out, D, ALPHA};
        pg8::gemm_phase<pg8::EpiResid, pg8::StaticOrder, true, true>(F.lds + RING_OFF, g, S, E);
        if (BOTH(9)) GRID_BAR();
    }
    if (IN(10)) { ln_rows(F, F.out, F.out, nullptr, F.in[21], F.in[22]); }
#undef IN
#undef BOTH
}

extern "C" void kernel_launch(void* const* d_in, const int* in_sizes, int n_in, void* d_out, int out_size, void* d_ws, size_t ws_size, hipStream_t stream) {
    static int grid = 0;
    if (grid == 0) {
        if (n_in != 23 || in_sizes[0] != M * D || out_size != M * D || ws_size < WS_END) { fprintf(stderr, "kernel_launch: unexpected shapes: n_in %d in0 %d out %d ws %zu\n", n_in, n_in > 0 ? in_sizes[0] : -1, out_size, ws_size); grid = -1; return; }
        int dev = 0, cus = 0, per_cu = 0;
        if (hipGetDevice(&dev) != hipSuccess || hipDeviceGetAttribute(&cus, hipDeviceAttributeMultiprocessorCount, dev) != hipSuccess) { grid = -1; return; }
        if (hipFuncSetAttribute((const void*)mk_fwd, hipFuncAttributeMaxDynamicSharedMemorySize, LDS_BYTES) != hipSuccess) { fprintf(stderr, "kernel_launch: hipFuncSetAttribute failed\n"); grid = -1; return; }
        if (hipOccupancyMaxActiveBlocksPerMultiprocessor(&per_cu, (const void*)mk_fwd, NWAVES * 64, LDS_BYTES) != hipSuccess || per_cu < 1)
            fprintf(stderr, "kernel_launch: note: occupancy query reports %d workgroups per CU\n", per_cu);
        (void)hipGetLastError();
        grid = cus;
    }
    if (grid < 0) return;
    if (hipMemsetAsync((char*)d_ws + WS_CTL, 0, CTL_ZERO_BYTES, stream) != hipSuccess) { fprintf(stderr, "kernel_launch: hipMemsetAsync failed\n"); return; }
    Args a{};
    for (int i = 0; i < 23; ++i) a.in[i] = (const float*)d_in[i];
    a.out = (float*)d_out; a.ws = (unsigned char*)d_ws;
#if defined(MK_DIAG)
    { static const int tab[][2] = {{0,0},{-1,1},{1,0},{-1,2},{2,0},{3,0},{-1,3},{4,0},{-1,4},{5,0},{-1,5},{6,0},{7,0},{-1,6},{8,0},{9,0},{-1,7},{10,0},{-1,8}};
      for (unsigned li = 0; li < sizeof(tab) / sizeof(tab[0]); ++li) { a.ph_lo = tab[li][0] < 0 ? 0 : tab[li][0]; a.ph_hi = tab[li][0] < 0 ? 0 : tab[li][0] + 1; a.li = 0; a.pad = tab[li][1];
        hipLaunchKernelGGL(mk_fwd, dim3(grid), dim3(NWAVES * 64), LDS_BYTES, stream, a); } }
#else
    for (int li = 0; li < N_LAUNCHES; ++li) {
        a.ph_lo = (N_LAUNCHES == 1) ? 0 : li; a.ph_hi = (N_LAUNCHES == 1) ? N_PHASES : li + 1; a.li = li;
        hipLaunchKernelGGL(mk_fwd, dim3(grid), dim3(NWAVES * 64), LDS_BYTES, stream, a);
        const hipError_t le = hipPeekAtLastError();
        if (le != hipSuccess) { fprintf(stderr, "kernel_launch: launch %d failed: %s\n", li, hipGetErrorName(le)); break; }
    }
#endif
}
```

```cpp
#define MK_N_LAUNCHES 1
#include <hip/hip_runtime.h>
#include <cstdio>
#include <cstdint>
namespace pg8 {
#define PG8_LAS __attribute__((address_space(3)))
typedef unsigned short bf16_t;
typedef short bf16x8 __attribute__((ext_vector_type(8)));
typedef float f32x4 __attribute__((ext_vector_type(4)));
typedef unsigned u32x4 __attribute__((ext_vector_type(4)));
constexpr int BM = 256, BK = 64, HALF = 128, HTB = HALF * BK * 2  , STAGE_BYTES = 8 * HTB, NXCD = 8, WGM = 8;

__host__ __device__ __forceinline__ int lds_byte(int r, int c) { const int st = (r >> 4) * 2 + (c >> 5), rr = r & 15, cc = c & 31, ob = rr * 64 + cc * 2; return st * 1024 + (ob ^ (((ob >> 9) & 1) << 5)); }
__host__ __device__ __forceinline__ void stage_rc(int b, int& R, int& C) { const int st = b / 1024, sb = b % 1024, swz = sb ^ (((sb >> 9) & 1) << 5); R = (st >> 1) * 16 + swz / 64; C = (st & 1) * 32 + (swz % 64) / 2; }
__host__ __device__ __forceinline__ int perm32(int rho) { const int n = rho >> 4, i = rho & 15; return 8 * (i >> 2) + 4 * n + (i & 3); }

struct Unit { int pm, pn; };
struct Gemm { const bf16_t* A; const bf16_t* Bt; int M, N, K; };

struct StaticOrder {
    int nM, nN, nwg, G, c;
    __host__ __device__ void init(int M, int N, int G_, int c_) { nM = M / BM; nN = N / BM; nwg = nM * nN; G = G_; c = c_; }
    __host__ __device__ bool next(int i, Unit& u) const {
        const long L = (long)i * G + c; if (L >= nwg) return false;
        int wgid = (int)L; { const int q = nwg / NXCD, r = nwg % NXCD, xcd = wgid % NXCD, off = wgid / NXCD; wgid = (xcd < r ? xcd * (q + 1) : r * (q + 1) + (xcd - r) * q) + off; }
        const int nig = WGM * nN, gid = wgid / nig, fm = gid * WGM, gsz = (nM - fm) < WGM ? (nM - fm) : WGM;
        u.pm = fm + ((wgid % nig) % gsz); u.pn = (wgid % nig) / gsz; return true;
    }
    __device__ __forceinline__ void a_ready(const Unit&) const {}
    __device__ __forceinline__ void done(const Unit&) const {}
};


typedef float f32x2_t __attribute__((ext_vector_type(2))); typedef __bf16 bf16x2_t __attribute__((ext_vector_type(2)));
__device__ __forceinline__ unsigned cvt_pk_bf16(float lo, float hi) { f32x2_t v = {lo, hi}; bf16x2_t b = __builtin_convertvector(v, bf16x2_t); return __builtin_bit_cast(unsigned, b); }
__device__ __forceinline__ float bflo(unsigned u) { return __uint_as_float(u << 16); }
__device__ __forceinline__ float bfhi(unsigned u) { return __uint_as_float(u & 0xffff0000u); }
__device__ __forceinline__ float sigmoid_f(float z) { return __builtin_amdgcn_rcpf(1.0f + __expf(-z)); }
__device__ __forceinline__ float gelu_tanh_f(float x) { const float u2 = 1.5957691216057308f * x * (1.0f + 0.044715f * x * x); return x * __builtin_amdgcn_rcpf(1.0f + __expf(-u2)); }

struct EpiProj {
    static constexpr bool PERM = true, AFTER_DRAIN = false;
    bf16_t* QKVA; bf16_t* ZB; bf16_t* QC;
    __device__ __forceinline__ void operator()(const f32x4 (&acc)[2][2][4][2], const Unit& u, int wr, int wc, int fr, int fq) const {
        const int pn = u.pn; bf16_t* base; int ldc, colt, mode;
        if (pn < 9) { base = QKVA; ldc = 2304; colt = pn * 256; mode = pn < 3 ? 1 : 0; }
        else if (pn < 13) { base = ZB; ldc = 1024; colt = (pn - 9) * 256; mode = 2; }
        else { base = QC; ldc = 256; colt = 0; mode = 1; }
        const int row0 = u.pm * BM + wr * 64 + fr, col0 = colt + wc * 32 + 8 * fq;
#pragma unroll
        for (int ai = 0; ai < 2; ++ai)
#pragma unroll
            for (int m = 0; m < 4; ++m) { bf16_t* rowp = base + (size_t)(row0 + ai * HALF + m * 16) * ldc + col0;
#pragma unroll
                for (int bj = 0; bj < 2; ++bj) { f32x4 v0 = acc[ai][bj][m][0], v1 = acc[ai][bj][m][1];
                    if (mode == 2) {
#pragma unroll
                        for (int i = 0; i < 4; ++i) { v0[i] = gelu_tanh_f(v0[i]); v1[i] = gelu_tanh_f(v1[i]); } }
                    else if (mode == 1) { v0 = v0 * 0.125f; v1 = v1 * 0.125f; }
                    u32x4 w; w.x = cvt_pk_bf16(v0[0], v0[1]); w.y = cvt_pk_bf16(v0[2], v0[3]); w.z = cvt_pk_bf16(v1[0], v1[1]); w.w = cvt_pk_bf16(v1[2], v1[3]);
                    *(u32x4*)(rowp + bj * HALF) = w; } }
    }
};
struct EpiPlain {
    static constexpr bool PERM = true, AFTER_DRAIN = false;
    bf16_t* O; int ldc;
    __device__ __forceinline__ void operator()(const f32x4 (&acc)[2][2][4][2], const Unit& u, int wr, int wc, int fr, int fq) const {
        const int row0 = u.pm * BM + wr * 64 + fr, col0 = u.pn * BM + wc * 32 + 8 * fq;
#pragma unroll
        for (int ai = 0; ai < 2; ++ai)
#pragma unroll
            for (int m = 0; m < 4; ++m) { bf16_t* rowp = O + (size_t)(row0 + ai * HALF + m * 16) * ldc + col0;
#pragma unroll
                for (int bj = 0; bj < 2; ++bj) { const f32x4 v0 = acc[ai][bj][m][0], v1 = acc[ai][bj][m][1];
                    u32x4 w; w.x = cvt_pk_bf16(v0[0], v0[1]); w.y = cvt_pk_bf16(v0[2], v0[3]); w.z = cvt_pk_bf16(v1[0], v1[1]); w.w = cvt_pk_bf16(v1[2], v1[3]);
                    *(u32x4*)(rowp + bj * HALF) = w; } }
    }
};
struct EpiGate {
    static constexpr bool PERM = true, AFTER_DRAIN = false;
    bf16_t* O; int ldc; const float* bias;
    __device__ __forceinline__ void operator()(const f32x4 (&acc)[2][2][4][2], const Unit& u, int wr, int wc, int fr, int fq) const {
        const int row0 = u.pm * BM + wr * 64 + fr, col0 = u.pn * BM + wc * 32 + 8 * fq;
        f32x4 bv[2][2];
#pragma unroll
        for (int bj = 0; bj < 2; ++bj)
#pragma unroll
            for (int n = 0; n < 2; ++n) bv[bj][n] = *(const f32x4*)(bias + col0 + bj * HALF + 4 * n);
#pragma unroll
        for (int ai = 0; ai < 2; ++ai)
#pragma unroll
            for (int m = 0; m < 4; ++m) { bf16_t* rowp = O + (size_t)(row0 + ai * HALF + m * 16) * ldc + col0;
#pragma unroll
                for (int bj = 0; bj < 2; ++bj) { f32x4 v0 = acc[ai][bj][m][0] + bv[bj][0], v1 = acc[ai][bj][m][1] + bv[bj][1];
#pragma unroll
                    for (int i = 0; i < 4; ++i) { v0[i] = sigmoid_f(v0[i]); v1[i] = sigmoid_f(v1[i]); }
                    u32x4 w; w.x = cvt_pk_bf16(v0[0], v0[1]); w.y = cvt_pk_bf16(v0[2], v0[3]); w.z = cvt_pk_bf16(v1[0], v1[1]); w.w = cvt_pk_bf16(v1[2], v1[3]);
                    *(u32x4*)(rowp + bj * HALF) = w; } }
    }
};
struct EpiMerge {
    static constexpr bool PERM = false, AFTER_DRAIN = false;
    const bf16_t* gates; float* mrg; bf16_t* merged; int br;
    __device__ __forceinline__ void operator()(const f32x4 (&acc)[2][2][4][2], const Unit& u, int wr, int wc, int fr, int fq) const {
        typedef unsigned u32x2v __attribute__((ext_vector_type(2)));
        const int row0 = u.pm * BM + wr * 64 + fr, col0 = u.pn * BM + wc * 32 + 4 * fq;
#pragma unroll
        for (int ai = 0; ai < 2; ++ai)
#pragma unroll
            for (int m = 0; m < 4; ++m) { const size_t r = (size_t)(row0 + ai * HALF + m * 16);
#pragma unroll
                for (int bj = 0; bj < 2; ++bj)
#pragma unroll
                    for (int n = 0; n < 2; ++n) { const int c = col0 + bj * HALF + n * 16;
                        const u32x2v gw = *(const u32x2v*)(gates + r * 3072 + br * 1024 + c);
                        f32x4 v = acc[ai][bj][m][n]; v[0] *= bflo(gw.x); v[1] *= bfhi(gw.x); v[2] *= bflo(gw.y); v[3] *= bfhi(gw.y);
                        float* mp = mrg + r * 1024 + c;
                        if (br == 0) { *(f32x4*)mp = v; }
                        else if (br == 1) { *(f32x4*)mp = *(const f32x4*)mp + v; }
                        else { v = v + *(const f32x4*)mp; u32x2v w; w.x = cvt_pk_bf16(v[0], v[1]); w.y = cvt_pk_bf16(v[2], v[3]); *(u32x2v*)(merged + r * 1024 + c) = w; } }
                asm volatile("" ::: "memory"); }
    }
};
struct EpiResid {
    static constexpr bool PERM = false, AFTER_DRAIN = false;
    const float* base; float* out; int ldc; float alpha;
    __device__ __forceinline__ void operator()(const f32x4 (&acc)[2][2][4][2], const Unit& u, int wr, int wc, int fr, int fq) const {
        const int row0 = u.pm * BM + wr * 64 + fr, col0 = u.pn * BM + wc * 32 + 4 * fq;
#pragma unroll
        for (int ai = 0; ai < 2; ++ai)
#pragma unroll
            for (int m = 0; m < 4; ++m) { const size_t off = (size_t)(row0 + ai * HALF + m * 16) * ldc + col0;
#pragma unroll
                for (int bj = 0; bj < 2; ++bj)
#pragma unroll
                    for (int n = 0; n < 2; ++n) { const f32x4 bs = *(const f32x4*)(base + off + bj * HALF + n * 16); *(f32x4*)(out + off + bj * HALF + n * 16) = bs * alpha + acc[ai][bj][m][n]; }
                asm volatile("" ::: "memory"); }
    }
};
struct EpiUp {
    static constexpr bool PERM = true, AFTER_DRAIN = false;
    bf16_t* Ap; bf16_t* Bp; int ldc;
    __device__ __forceinline__ void operator()(const f32x4 (&acc)[2][2][4][2], const Unit& u, int wr, int wc, int fr, int fq) const {
        const int row0 = u.pm * BM + wr * 64 + fr, col0 = u.pn * HALF + wc * 32 + 8 * fq;
#pragma unroll
        for (int ai = 0; ai < 2; ++ai)
#pragma unroll
            for (int m = 0; m < 4; ++m) { const size_t off = (size_t)(row0 + ai * HALF + m * 16) * ldc + col0;
#pragma unroll
                for (int bj = 0; bj < 2; ++bj) { const f32x4 v0 = acc[ai][bj][m][0], v1 = acc[ai][bj][m][1];
                    u32x4 w; w.x = cvt_pk_bf16(v0[0], v0[1]); w.y = cvt_pk_bf16(v0[2], v0[3]); w.z = cvt_pk_bf16(v1[0], v1[1]); w.w = cvt_pk_bf16(v1[2], v1[3]);
                    *(u32x4*)((bj == 0 ? Ap : Bp) + off) = w; } }
    }
};

template <class Epi, class Sched, bool ALIGN_EPI = false, bool SP2 = false>
__device__ __forceinline__ void gemm_phase(PG8_LAS unsigned char* lds, const Gemm g, const Sched& S, const Epi& E) {
    const int tid = threadIdx.x, wid = __builtin_amdgcn_readfirstlane(tid >> 6), lane = tid & 63, wr = wid >> 2, wc = wid & 3, fr = lane & 15, fq = lane >> 4;
    const int K = g.K, nt = K / BK;
    unsigned voffA[2], voffB[2];
#pragma unroll
    for (int i = 0; i < 2; ++i) { int R, C; stage_rc(tid * 16 + i * 8192, R, C); const int Rb = Epi::PERM ? ((R & ~31) + perm32(R & 31)) : R;
        voffA[i] = (unsigned)(R * K + C) * 2u; voffB[i] = (unsigned)(Rb * K + C) * 2u; }
    const size_t kstep = (size_t)(BK * 2);
    const size_t hstep = (size_t)HALF * K * 2;
    const size_t tstep = 2 * hstep;
    const unsigned ldsw = (unsigned)wid * 1024u;
    const int aoff = lds_byte(wr * 64 + fr, fq * 8), boff = lds_byte(wc * 32 + fr, fq * 8);
#define PG8_SA(b, h) (((b) * 2 + (h)) * HTB)
#define PG8_SB(b, h) ((4 + (b) * 2 + (h)) * HTB)
#define PG8_STAGE(bufoff, gbase, voff) do { _Pragma("unroll") for (int _i = 0; _i < 2; ++_i) \
        __builtin_amdgcn_global_load_lds((const unsigned*)((const char*)(gbase) + (voff)[_i]), (PG8_LAS unsigned*)(lds + (bufoff) + ldsw + _i * 8192), 16, 0, 0); } while (0)
#define PG8_LDA(dst, b, h) do { _Pragma("unroll") for (int m = 0; m < 4; ++m) _Pragma("unroll") for (int k = 0; k < 2; ++k) dst[m][k] = *(const PG8_LAS bf16x8*)(lds + PG8_SA(b, h) + aoff + m * 2048 + k * 1024); } while (0)
#define PG8_LDB(dst, b, h) do { _Pragma("unroll") for (int n = 0; n < 2; ++n) _Pragma("unroll") for (int k = 0; k < 2; ++k) dst[n][k] = *(const PG8_LAS bf16x8*)(lds + PG8_SB(b, h) + boff + n * 2048 + k * 1024); } while (0)
#define PG8_MMA(ai, bj, At, Bt) do { __builtin_amdgcn_s_setprio(1); _Pragma("unroll") for (int m = 0; m < 4; ++m) _Pragma("unroll") for (int n = 0; n < 2; ++n) _Pragma("unroll") for (int k = 0; k < 2; ++k) \
        acc[ai][bj][m][n] = __builtin_amdgcn_mfma_f32_16x16x32_bf16(Bt[n][k], At[m][k], acc[ai][bj][m][n], 0, 0, 0); __builtin_amdgcn_s_setprio(0); } while (0)
#define PG8_WAIT_V(n) asm volatile("s_waitcnt vmcnt(" #n ")" ::: "memory")
#define PG8_WAIT_L(n) asm volatile("s_waitcnt lgkmcnt(" #n ")" ::: "memory")
#define PG8_BAR __builtin_amdgcn_s_barrier()
#define PG8_SCHED __builtin_amdgcn_sched_barrier(0)
    Unit cur, nxt; int ui = 0;
    if (!S.next(0, cur)) return;
    f32x4 acc[2][2][4][2];
#pragma unroll
    for (int a = 0; a < 2; ++a)
#pragma unroll
        for (int b = 0; b < 2; ++b)
#pragma unroll
            for (int m = 0; m < 4; ++m)
#pragma unroll
                for (int n = 0; n < 2; ++n) acc[a][b][m][n] = (f32x4){0.f, 0.f, 0.f, 0.f};
    bf16x8 At[4][2], B0[2][2], B1[2][2];
    const char* cA = (const char*)g.A + (size_t)cur.pm * tstep; const char* cB = (const char*)g.Bt + (size_t)cur.pn * tstep;
    S.a_ready(cur);
    if constexpr (SP2) {
        PG8_STAGE(PG8_SB(0, 0), cB, voffB); PG8_STAGE(PG8_SB(0, 1), cB + hstep, voffB); PG8_STAGE(PG8_SA(0, 0), cA, voffA); PG8_STAGE(PG8_SA(0, 1), cA + hstep, voffA);
        if (wr == 1) PG8_BAR;
        PG8_WAIT_V(2); PG8_BAR;
        PG8_STAGE(PG8_SB(1, 0), cB + kstep, voffB); PG8_STAGE(PG8_SA(1, 0), cA + kstep, voffA); PG8_STAGE(PG8_SB(1, 1), cB + hstep + kstep, voffB);
        PG8_WAIT_V(6); PG8_BAR;
    } else {
        PG8_STAGE(PG8_SB(0, 0), cB, voffB); PG8_STAGE(PG8_SA(0, 0), cA, voffA); PG8_STAGE(PG8_SB(0, 1), cB + hstep, voffB); PG8_STAGE(PG8_SA(0, 1), cA + hstep, voffA);
        if (wr == 1) PG8_BAR;
        PG8_WAIT_V(4); PG8_BAR;
        PG8_STAGE(PG8_SB(1, 0), cB + kstep, voffB); PG8_STAGE(PG8_SA(1, 0), cA + kstep, voffA); PG8_STAGE(PG8_SB(1, 1), cB + hstep + kstep, voffB);
        PG8_WAIT_V(6); PG8_BAR;
    }
    for (;;) {
        const bool has_next = S.next(ui + 1, nxt);
        const char* nA = has_next ? (const char*)g.A + (size_t)nxt.pm * tstep : cA; const char* nB = has_next ? (const char*)g.Bt + (size_t)nxt.pn * tstep : cB;
        for (int t = 0; t < nt; t += 2) {
            const bool last = (t == nt - 2);
            const char* a1 = cA + (size_t)(t + 1) * kstep;
            const char* a2 = last ? nA : cA + (size_t)(t + 2) * kstep; const char* b2 = last ? nB : cB + (size_t)(t + 2) * kstep;
            const char* a3 = a2 + kstep; const char* b3 = b2 + kstep;
            if (last && has_next) S.a_ready(nxt);
            if constexpr (SP2) {
            PG8_LDB(B0, 0, 0); PG8_LDB(B1, 0, 1); PG8_SCHED; PG8_LDA(At, 0, 0); PG8_STAGE(PG8_SA(1, 1), a1 + hstep, voffA);
            PG8_WAIT_V(8); PG8_WAIT_L(0); PG8_BAR; PG8_MMA(0, 0, At, B0); PG8_MMA(0, 1, At, B1); PG8_BAR; PG8_SCHED;
            PG8_LDA(At, 0, 1); PG8_STAGE(PG8_SB(0, 0), b2, voffB); PG8_STAGE(PG8_SB(0, 1), b2 + hstep, voffB); PG8_STAGE(PG8_SA(0, 0), a2, voffA);
            PG8_WAIT_V(8); PG8_WAIT_L(0); PG8_BAR; PG8_MMA(1, 0, At, B0); PG8_MMA(1, 1, At, B1); PG8_BAR; PG8_SCHED;
            PG8_LDB(B0, 1, 0); PG8_LDB(B1, 1, 1); PG8_SCHED; PG8_LDA(At, 1, 0); PG8_STAGE(PG8_SA(0, 1), a2 + hstep, voffA);
            PG8_WAIT_V(8); PG8_WAIT_L(0); PG8_BAR; PG8_MMA(0, 0, At, B0); PG8_MMA(0, 1, At, B1); PG8_BAR; PG8_SCHED;
            PG8_LDA(At, 1, 1); PG8_STAGE(PG8_SB(1, 0), b3, voffB); PG8_STAGE(PG8_SB(1, 1), b3 + hstep, voffB); PG8_STAGE(PG8_SA(1, 0), a3, voffA);
            PG8_WAIT_V(8); PG8_WAIT_L(0); PG8_BAR; PG8_MMA(1, 0, At, B0); PG8_MMA(1, 1, At, B1); PG8_BAR; PG8_SCHED;
            } else {
            PG8_LDB(B0, 0, 0); PG8_SCHED; PG8_LDA(At, 0, 0); PG8_STAGE(PG8_SA(1, 1), a1 + hstep, voffA);
            PG8_WAIT_L(8); PG8_BAR; PG8_WAIT_L(0); PG8_MMA(0, 0, At, B0); PG8_BAR; PG8_SCHED;
            PG8_LDB(B1, 0, 1); PG8_STAGE(PG8_SB(0, 0), b2, voffB);
            PG8_BAR; PG8_WAIT_L(0); PG8_MMA(0, 1, At, B1); PG8_BAR;
            PG8_LDA(At, 0, 1); PG8_STAGE(PG8_SA(0, 0), a2, voffA);
            PG8_BAR; PG8_WAIT_L(0); PG8_MMA(1, 0, At, B0); PG8_BAR; PG8_SCHED;
            PG8_STAGE(PG8_SB(0, 1), b2 + hstep, voffB);
            PG8_WAIT_V(6); PG8_BAR; PG8_MMA(1, 1, At, B1); PG8_BAR;
            PG8_LDB(B0, 1, 0); PG8_SCHED; PG8_LDA(At, 1, 0); PG8_STAGE(PG8_SA(0, 1), a2 + hstep, voffA);
            PG8_WAIT_L(8); PG8_BAR; PG8_WAIT_L(0); PG8_MMA(0, 0, At, B0); PG8_BAR; PG8_SCHED;
            PG8_LDB(B1, 1, 1); PG8_STAGE(PG8_SB(1, 0), b3, voffB);
            PG8_BAR; PG8_WAIT_L(0); PG8_MMA(0, 1, At, B1); PG8_BAR;
            PG8_LDA(At, 1, 1); PG8_STAGE(PG8_SA(1, 0), a3, voffA);
            PG8_BAR; PG8_WAIT_L(0); PG8_MMA(1, 0, At, B0); PG8_BAR; PG8_SCHED;
            PG8_STAGE(PG8_SB(1, 1), b3 + hstep, voffB);
            PG8_WAIT_V(6); PG8_BAR; PG8_MMA(1, 1, At, B1); PG8_BAR;
            }
        }
        if constexpr (ALIGN_EPI) { if (wr == 0) PG8_BAR; }
        if constexpr (!Epi::AFTER_DRAIN) { E(acc, cur, wr, wc, fr, fq); S.done(cur); }
        if (!has_next) break;
#pragma unroll
        for (int a = 0; a < 2; ++a)
#pragma unroll
            for (int b = 0; b < 2; ++b)
#pragma unroll
                for (int m = 0; m < 4; ++m)
#pragma unroll
                    for (int n = 0; n < 2; ++n) acc[a][b][m][n] = (f32x4){0.f, 0.f, 0.f, 0.f};
        cur = nxt; cA = nA; cB = nB; ++ui;
        if constexpr (ALIGN_EPI) { if (wr == 1) PG8_BAR; }
    }
    PG8_WAIT_V(0);
    if constexpr (!ALIGN_EPI) { if (wr == 0) PG8_BAR; }
    PG8_BAR;
    if constexpr (Epi::AFTER_DRAIN) { E.fused(acc, cur, wr, wc, fr, fq, lds, wid, lane); S.done(cur); }
#undef PG8_SA
#undef PG8_SB
#undef PG8_STAGE
#undef PG8_LDA
#undef PG8_LDB
#undef PG8_MMA
#undef PG8_WAIT_V
#undef PG8_WAIT_L
#undef PG8_BAR
#undef PG8_SCHED
}
}
#define GAS __attribute__((address_space(1)))
#define LAS __attribute__((address_space(3)))
typedef unsigned short bf16;
typedef unsigned v4u __attribute__((ext_vector_type(4)));
typedef float f32x4 __attribute__((ext_vector_type(4)));
typedef short bf16x8 __attribute__((ext_vector_type(8)));
typedef GAS unsigned gu32;
typedef GAS unsigned long long gu64;
#define RLX_AGENT __ATOMIC_RELAXED, __HIP_MEMORY_SCOPE_AGENT
#define LDS_WAIT() asm volatile("s_waitcnt lgkmcnt(0)" ::: "memory")
#define VM_WAIT() asm volatile("s_waitcnt vmcnt(0)" ::: "memory")
__device__ __forceinline__ unsigned long long rt() { return __builtin_amdgcn_s_memrealtime(); }
__device__ __forceinline__ unsigned f2bf(float f) { unsigned u = __builtin_bit_cast(unsigned, f); return (u + 0x7fffu + ((u >> 16) & 1u)) >> 16; }
__device__ __forceinline__ unsigned pk2(float lo, float hi) { return f2bf(lo) | (f2bf(hi) << 16); }

#define XB_TMO      128
#define XB_XCNT(j)  (256  + 64 * (j))
#define XB_XSUB(j)  (1280 + 64 * (j))
#define XB_XGEN(j)  (2304 + 64 * (j))
#define XB_TOP      3328
#define XB_TOPGEN   3392
#define XCD_BAR_WORDS 3456
#define XB_SPIN_CAP (1u << 18)

__device__ __forceinline__ unsigned xb_ld(unsigned* p)              { return __hip_atomic_load(p, __ATOMIC_RELAXED, __HIP_MEMORY_SCOPE_AGENT); }
__device__ __forceinline__ unsigned xb_add(unsigned* p, unsigned v) { return __hip_atomic_fetch_add(p, v, __ATOMIC_RELAXED, __HIP_MEMORY_SCOPE_AGENT); }
__device__ __forceinline__ unsigned xb_xcc_id() { return (unsigned)__builtin_amdgcn_s_getreg((3 << 11) | 20) & 0xFu; }
#define XB_SPIN(cond, bar) do { unsigned _sp = 0; while (cond) { __builtin_amdgcn_s_sleep(1); \
    if ((++_sp & 255u) == 0u) { if (xb_ld(&(bar)[XB_TMO])) break; if (_sp > XB_SPIN_CAP) { atomicAdd(&(bar)[XB_TMO], 1u); break; } } } } while (0)

struct XcdBarrier {
    unsigned* bar; unsigned x;
    volatile LAS unsigned* st;
};

__device__ __forceinline__ XcdBarrier xcd_barrier_post(unsigned* bar, volatile LAS unsigned* st) {
    XcdBarrier b; b.bar = bar; b.x = xb_xcc_id(); b.st = st;
    if (threadIdx.x == 0) (void)xb_add(&bar[XB_XCNT(b.x)], 1u);
    return b;
}
__device__ __forceinline__ void xcd_barrier_complete(unsigned* bar, unsigned x, unsigned& nloc, unsigned& nx) {
    const unsigned G = gridDim.x * gridDim.y * gridDim.z;
    unsigned sum, cnt, mine, sp = 0u;
    for (;;) {
        sum = 0u; cnt = 0u; mine = 0u;
#pragma unroll
        for (unsigned j = 0; j < 16; ++j) { const unsigned c = xb_ld(&bar[XB_XCNT(j)]); sum += c; cnt += (c > 0u) ? 1u : 0u; mine = (j == x) ? c : mine; }
        if (sum == G) break;
        __builtin_amdgcn_s_sleep(1);
        if ((++sp & 255u) == 0u) { if (xb_ld(&bar[XB_TMO])) break; if (sp > XB_SPIN_CAP) { atomicAdd(&bar[XB_TMO], 1u); break; } }
    }
    nloc = mine > 0u ? mine : 1u; nx = cnt > 0u ? cnt : 1u;
}

__device__ __forceinline__ void xcd_barrier(const XcdBarrier& b) {
    asm volatile("s_waitcnt vmcnt(0)" ::: "memory");
    __syncthreads();
    if (threadIdx.x == 0) {
        unsigned* bar = b.bar;
        __builtin_amdgcn_s_waitcnt(0);
        unsigned nloc = b.st[0], nx = b.st[1];
        if (nloc == 0u) { xcd_barrier_complete(bar, b.x, nloc, nx); b.st[0] = nloc; b.st[1] = nx; }
        const unsigned old = xb_add(&bar[XB_XSUB(b.x)], 1u);
        const unsigned gen = old / nloc;
        if (old + 1u == (gen + 1u) * nloc) {
            __builtin_amdgcn_fence(__ATOMIC_RELEASE, "agent");
            asm volatile("s_waitcnt vmcnt(0)" ::: "memory");
            const unsigned og = xb_add(&bar[XB_TOP], 1u);
            const unsigned tg = og / nx;
            if (og + 1u == (tg + 1u) * nx) xb_add(&bar[XB_TOPGEN], 1u);
            else XB_SPIN(xb_ld(&bar[XB_TOPGEN]) == tg, bar);
            __builtin_amdgcn_fence(__ATOMIC_ACQUIRE, "agent");
            xb_add(&bar[XB_XGEN(b.x)], 1u);
            asm volatile("s_waitcnt vmcnt(0)" ::: "memory");
        } else {
            XB_SPIN(xb_ld(&bar[XB_XGEN(b.x)]) == gen, bar);
            __builtin_amdgcn_fence(__ATOMIC_ACQUIRE, "agent");
            asm volatile("s_waitcnt vmcnt(0)" ::: "memory");
        }
    }
    __syncthreads();
}

constexpr int NWAVES = 8;
#ifndef MK_N_LAUNCHES
#define MK_N_LAUNCHES 1
#endif
constexpr int N_PHASES = 11;
constexpr int N_LAUNCHES = MK_N_LAUNCHES;

constexpr int BATCH = 8, SEQ = 4096, D = 1024, M = BATCH * SEQ;
constexpr int ATTN_W = 768, QKV_W = 3 * ATTN_W, SG_W = 512, MEM_LEN = 256, MEM_W = 256, IN_W = 3584, GATE_W = 3072, DFF = 2816, UP_W = 2 * DFF;
constexpr float LN_EPS = 1e-5f;
constexpr float ALPHA = 1.189207115002721f;

constexpr size_t MiB = 1u << 20;
constexpr size_t WS_CTL = 0, CTL_ZERO_BYTES = 1 * MiB;
constexpr size_t WS_BT = 1 * MiB;
constexpr size_t WS_WIN = 2 * MiB, WS_WG = 9 * MiB, WS_WMKV = 15 * MiB, WS_WA = 16 * MiB, WS_WB = WS_WA + MiB / 2, WS_WC = WS_WB + MiB, WS_WOUT = 18 * MiB, WS_WUP = 20 * MiB, WS_WDN = 31 * MiB;
constexpr size_t WS_KVM = 37 * MiB;
constexpr size_t WS_MEMB = 39 * MiB;
constexpr size_t WS_XB = 44 * MiB;
constexpr size_t WS_HB = WS_XB;
constexpr size_t WS_QKVA = 108 * MiB, WS_ZB = 252 * MiB, WS_QC = 316 * MiB;
constexpr size_t WS_OA = 332 * MiB, WS_OB = 348 * MiB, WS_OC = 380 * MiB;
constexpr size_t WS_MERGED = 396 * MiB;
constexpr size_t WS_GATES = 108 * MiB;
constexpr size_t WS_AP = 108 * MiB, WS_BP = 284 * MiB;
constexpr size_t WS_END = 460 * MiB;
constexpr size_t WS_OG = 460 * MiB, WS_LSE = 508 * MiB;
constexpr size_t WS_OA2 = 396 * MiB, WS_OB2 = 412 * MiB, WS_OC2 = 444 * MiB;
constexpr size_t WS_TOTAL = 510 * MiB;
static_assert(WS_WDN + (size_t)D * DFF * 2 <= WS_KVM && WS_GATES + (size_t)M * GATE_W * 2 <= WS_QC && WS_BP + (size_t)M * DFF * 2 <= WS_END && WS_AP + (size_t)M * DFF * 2 <= WS_BP, "d_ws map");
constexpr int CW_TMO = 0, CW_CODE = 1;
constexpr int CW_BAR = 4096;
constexpr int CW_SEAM = 16384, SEAM_BANK = 128 * 64;

constexpr int RING_OFF = 0, RING_BYTES = 131072;
constexpr int LDSCTL_OFF = RING_BYTES, MISC_OFF = LDSCTL_OFF + 320;
constexpr int LDS_BYTES = 147456;

struct Frame {
    LAS unsigned char* lds;
    volatile LAS unsigned* MISC;
    gu32* ctl;
    int tid, lane, wave;
    int vcu, G;
    const float* in[23];
    float* out;
    unsigned char* ws;
};
__device__ __forceinline__ float wave_sum(float v) {
#pragma unroll
    for (int o = 1; o < 64; o <<= 1) v += __shfl_xor(v, o);
    return v;
}
__device__ __forceinline__ float bf2f(bf16 h) { return __uint_as_float((unsigned)h << 16); }
__device__ __forceinline__ float bflo_(unsigned u) { return __uint_as_float(u << 16); }
__device__ __forceinline__ float bfhi_(unsigned u) { return __uint_as_float(u & 0xffff0000u); }
__device__ __forceinline__ void unpack8(const v4u w, float (&f)[8]) { f[0] = bflo_(w.x); f[1] = bfhi_(w.x); f[2] = bflo_(w.y); f[3] = bfhi_(w.y); f[4] = bflo_(w.z); f[5] = bfhi_(w.z); f[6] = bflo_(w.w); f[7] = bfhi_(w.w); }
__device__ __forceinline__ float gelu_tanh(float x) { const float u2 = 1.5957691216057308f * x * (1.0f + 0.044715f * x * x); return x * __builtin_amdgcn_rcpf(1.0f + __expf(-u2)); }

__device__ __forceinline__ void p0_transpose_item(const float* W, int K, int N, bf16* WT, int ldt, int koff, int mode, LAS float* scr, int item, int lane) {
    const int nblk = N / 32, kb = item / nblk, nb = item % nblk, k0 = 64 * kb, n0 = 32 * nb;
#pragma unroll 8
    for (int i = 0; i < 32; ++i) { const int kk = 2 * i + (lane >> 5); scr[kk * 33 + (lane & 31)] = W[(size_t)(k0 + kk) * N + n0 + (lane & 31)]; }
    LDS_WAIT(); asm volatile("" ::: "memory");
    int r0 = n0;
    if (mode == 1) { r0 = (n0 < DFF) ? (256 * (n0 / 128) + (n0 % 128)) : (256 * ((n0 - DFF) / 128) + 128 + ((n0 - DFF) % 128)); }
    const int c = lane & 7;
#pragma unroll
    for (int j = 0; j < 4; ++j) { const int n = (lane >> 3) + 8 * j; const LAS float* s = scr + (8 * c) * 33 + n;
        v4u o; o.x = pk2(s[0 * 33], s[1 * 33]); o.y = pk2(s[2 * 33], s[3 * 33]); o.z = pk2(s[4 * 33], s[5 * 33]); o.w = pk2(s[6 * 33], s[7 * 33]);
        *(GAS v4u*)(WT + (size_t)(r0 + n) * ldt + koff + k0 + 8 * c) = o; }
    LDS_WAIT(); asm volatile("" ::: "memory");
}
__device__ __forceinline__ void cvt_rows_bf16(Frame& F, const float* src, bf16* dst, size_t n8) {
    const size_t gid = (size_t)F.vcu * 512 + F.tid, NT = (size_t)F.G * 512;
    for (size_t i = gid; i < n8; i += NT) { const f32x4 a = *(const GAS f32x4*)(src + i * 8), b = *(const GAS f32x4*)(src + i * 8 + 4);
        v4u o; o.x = pk2(a.x, a.y); o.y = pk2(a.z, a.w); o.z = pk2(b.x, b.y); o.w = pk2(b.z, b.w); *(GAS v4u*)(dst + i * 8) = o; }
}
__device__ __forceinline__ int t5_bucket(int dist) {
    if (dist < 16) return dist;
    int large = 16 + (int)(log((double)dist / 16.0) / log(128.0) * 16.0);
    return large < 31 ? large : 31;
}
__device__ __forceinline__ void p0_prologue(Frame& F) {
    LAS float* scr = (LAS float*)(F.lds + RING_OFF + F.wave * 16384);
    const int gw = F.vcu * NWAVES + F.wave, NGW = F.G * NWAVES;
    unsigned char* ws = F.ws;
    constexpr int I_IN = (D / 64) * (IN_W / 32), I_G = (D / 64) * (GATE_W / 32), I_MKV = (D / 64) * (512 / 32), I_A = (256 / 64) * (D / 32), I_B = (512 / 64) * (D / 32), I_C = I_A,
                  I_OUT = (D / 64) * (D / 32), I_UP = (D / 64) * (UP_W / 32), I_DN = (DFF / 64) * (D / 32);
    constexpr int NITEMS = I_IN + I_G + I_MKV + I_A + I_B + I_C + I_OUT + I_UP + I_DN;
    for (int it = gw; it < NITEMS; it += NGW) {
        int r = it;
        if (r < I_IN) { p0_transpose_item(F.in[3], D, IN_W, (bf16*)(ws + WS_WIN), D, 0, 0, scr, r, F.lane); continue; } r -= I_IN;
        if (r < I_G) { p0_transpose_item(F.in[12], D, GATE_W, (bf16*)(ws + WS_WG), D, 0, 0, scr, r, F.lane); continue; } r -= I_G;
        if (r < I_MKV) { p0_transpose_item(F.in[4], D, 512, (bf16*)(ws + WS_WMKV), D, 0, 0, scr, r, F.lane); continue; } r -= I_MKV;
        if (r < I_A) { p0_transpose_item(F.in[9], 256, D, (bf16*)(ws + WS_WA), 256, 0, 0, scr, r, F.lane); continue; } r -= I_A;
        if (r < I_B) { p0_transpose_item(F.in[10], 512, D, (bf16*)(ws + WS_WB), 512, 0, 0, scr, r, F.lane); continue; } r -= I_B;
        if (r < I_C) { p0_transpose_item(F.in[11], 256, D, (bf16*)(ws + WS_WC), 256, 0, 0, scr, r, F.lane); continue; } r -= I_C;
        if (r < I_OUT) { p0_transpose_item(F.in[14], D, D, (bf16*)(ws + WS_WOUT), D, 0, 0, scr, r, F.lane); continue; } r -= I_OUT;
        if (r < I_UP) { p0_transpose_item(F.in[17], D, UP_W, (bf16*)(ws + WS_WUP), D, 0, 1, scr, r, F.lane); continue; } r -= I_UP;
        p0_transpose_item(F.in[20], DFF, D, (bf16*)(ws + WS_WDN), DFF, 0, 0, scr, r, F.lane);
    }
    cvt_rows_bf16(F, F.in[0], (bf16*)(ws + WS_XB), (size_t)M * D / 8);
    cvt_rows_bf16(F, F.in[1], (bf16*)(ws + WS_MEMB), (size_t)BATCH * MEM_LEN * D / 8);
    if (blockIdx.x == 0) { float* BT = (float*)(ws + WS_BT); const float* rb = F.in[2];
        for (int i = F.tid; i < 12 * 129; i += 512) { const int gh = i / 129, j = i % 129, g = gh >> 2, dil = g == 0 ? 1 : (g == 1 ? 4 : 16);
            BT[gh * 132 + j] = rb[t5_bucket(j * dil) * 12 + gh]; } }
}

__device__ __forceinline__ void p2_attn_simple(Frame& F) {
    const bf16* QKVA = (const bf16*)(F.ws + WS_QKVA); const float* BT = (const float*)(F.ws + WS_BT); bf16* OA = (bf16*)(F.ws + WS_OA);
    const int gid = F.vcu * 512 + F.tid, NT = F.G * 512;
    for (int it = gid; it < 4 * M; it += NT) {
        const int h = it / M, m = it % M, t = m % SEQ;
        float mx = -1e30f, l = 0.f; float o[64];
#pragma unroll
        for (int e = 0; e < 64; ++e) o[e] = 0.f;
        for (int g = 0; g < 3; ++g) {
            const int dil = g == 0 ? 1 : (g == 1 ? 4 : 16);
            const bf16* qp = QKVA + (size_t)m * QKV_W + g * 256 + h * 64;
            float q[64];
#pragma unroll
            for (int c = 0; c < 8; ++c) { float f[8]; unpack8(*(const GAS v4u*)(qp + c * 8), f);
#pragma unroll
                for (int i = 0; i < 8; ++i) q[c * 8 + i] = f[i]; }
            const float* bt = BT + (g * 4 + h) * 132;
            const int jmax = (t / dil) < 128 ? (t / dil) : 128;
            for (int j = 0; j <= jmax; ++j) {
                const bf16* kp = QKVA + (size_t)(m - j * dil) * QKV_W + ATTN_W + g * 256 + h * 64;
                float s = 0.f;
#pragma unroll
                for (int c = 0; c < 8; ++c) { float f[8]; unpack8(*(const GAS v4u*)(kp + c * 8), f);
#pragma unroll
                    for (int i = 0; i < 8; ++i) s += q[c * 8 + i] * f[i]; }
                s += bt[j];
                if (s > mx) { const float fs = __expf(mx - s); l *= fs;
#pragma unroll
                    for (int e = 0; e < 64; ++e) o[e] *= fs;
                    mx = s; }
                const float p = __expf(s - mx); l += p;
                const bf16* vp = kp + ATTN_W;
#pragma unroll
                for (int c = 0; c < 8; ++c) { float f[8]; unpack8(*(const GAS v4u*)(vp + c * 8), f);
#pragma unroll
                    for (int i = 0; i < 8; ++i) o[c * 8 + i] += p * f[i]; }
            }
        }
        const float rl = 1.0f / l; bf16* op = OA + (size_t)m * 256 + h * 64;
#pragma unroll
        for (int c = 0; c < 8; ++c) { v4u w; w.x = pk2(o[c * 8] * rl, o[c * 8 + 1] * rl); w.y = pk2(o[c * 8 + 2] * rl, o[c * 8 + 3] * rl); w.z = pk2(o[c * 8 + 4] * rl, o[c * 8 + 5] * rl); w.w = pk2(o[c * 8 + 6] * rl, o[c * 8 + 7] * rl);
            *(GAS v4u*)(op + c * 8) = w; }
    }
}
__device__ __forceinline__ void p2_cross_simple(Frame& F) {
    const bf16* QC = (const bf16*)(F.ws + WS_QC); const bf16* KVM = (const bf16*)(F.ws + WS_KVM); bf16* OC = (bf16*)(F.ws + WS_OC);
    const int gid = F.vcu * 512 + F.tid, NT = F.G * 512;
    for (int it = gid; it < 4 * M; it += NT) {
        const int h = it / M, m = it % M, b = m / SEQ;
        float mx = -1e30f, l = 0.f; float o[64], q[64];
#pragma unroll
        for (int e = 0; e < 64; ++e) o[e] = 0.f;
        const bf16* qp = QC + (size_t)m * 256 + h * 64;
#pragma unroll
        for (int c = 0; c < 8; ++c) { float f[8]; unpack8(*(const GAS v4u*)(qp + c * 8), f);
#pragma unroll
            for (int i = 0; i < 8; ++i) q[c * 8 + i] = f[i]; }
        for (int j = 0; j < MEM_LEN; ++j) {
            const bf16* kp = KVM + (size_t)(b * MEM_LEN + j) * 512 + h * 64;
            float s = 0.f;
#pragma unroll
            for (int c = 0; c < 8; ++c) { float f[8]; unpack8(*(const GAS v4u*)(kp + c * 8), f);
#pragma unroll
                for (int i = 0; i < 8; ++i) s += q[c * 8 + i] * f[i]; }
            if (s > mx) { const float fs = __expf(mx - s); l *= fs;
#pragma unroll
                for (int e = 0; e < 64; ++e) o[e] *= fs;
                mx = s; }
            const float p = __expf(s - mx); l += p;
            const bf16* vp = kp + 256;
#pragma unroll
            for (int c = 0; c < 8; ++c) { float f[8]; unpack8(*(const GAS v4u*)(vp + c * 8), f);
#pragma unroll
                for (int i = 0; i < 8; ++i) o[c * 8 + i] += p * f[i]; }
        }
        const float rl = 1.0f / l; bf16* op = OC + (size_t)m * 256 + h * 64;
#pragma unroll
        for (int c = 0; c < 8; ++c) { v4u w; w.x = pk2(o[c * 8] * rl, o[c * 8 + 1] * rl); w.y = pk2(o[c * 8 + 2] * rl, o[c * 8 + 3] * rl); w.z = pk2(o[c * 8 + 4] * rl, o[c * 8 + 5] * rl); w.w = pk2(o[c * 8 + 6] * rl, o[c * 8 + 7] * rl);
            *(GAS v4u*)(op + c * 8) = w; }
    }
}
__device__ __forceinline__ void p2_spatial_simple(Frame& F) {
    const bf16* ZB = (const bf16*)(F.ws + WS_ZB); bf16* OB = (bf16*)(F.ws + WS_OB);
    LAS float* st = (LAS float*)(F.lds + RING_OFF);
    const float* lng = F.in[5]; const float* lnb = F.in[6]; const float* wsp = F.in[7]; const float* bsp = F.in[8];
    for (int item = F.vcu; item < M / 128; item += F.G) {
        const int m0 = item * 128;
        for (int i = 0; i < 16; ++i) { const int tok = F.wave * 16 + i; float f[8]; unpack8(*(const GAS v4u*)(ZB + (size_t)(m0 + tok) * 1024 + 512 + F.lane * 8), f);
            float s = 0.f;
#pragma unroll
            for (int k = 0; k < 8; ++k) s += f[k];
            const float mean = wave_sum(s) * (1.0f / 512.0f); float s2 = 0.f;
#pragma unroll
            for (int k = 0; k < 8; ++k) { const float dd = f[k] - mean; s2 += dd * dd; }
            const float rstd = 1.0f / sqrtf(wave_sum(s2) * (1.0f / 512.0f) + LN_EPS);
            if (F.lane == 0) { st[tok * 2] = mean; st[tok * 2 + 1] = rstd; } }
        __syncthreads();
        const int ch = F.tid, g = ch >> 6; const float lg = lng[ch], lb = lnb[ch];
        for (int p = 0; p < 128; ++p) {
            const float* wrow = wsp + (size_t)(g * 128 + p) * 128; float acc = 0.f;
            for (int q = 0; q <= p; ++q) { const float vv = bf2f(ZB[(size_t)(m0 + q) * 1024 + 512 + ch]); const float vn = (vv - st[2 * q]) * st[2 * q + 1] * lg + lb; acc += wrow[q] * vn; }
            const float u = bf2f(ZB[(size_t)(m0 + p) * 1024 + ch]);
            OB[(size_t)(m0 + p) * 512 + ch] = (bf16)f2bf(u * (acc + bsp[g * 128 + p]));
        }
        __syncthreads();
    }
}
__device__ __forceinline__ void ln_rows(Frame& F, const float* src, float* dst32, bf16* dstb, const float* g, const float* b) {
    const int gw = F.vcu * NWAVES + F.wave, NGW = F.G * NWAVES;
    f32x4 gv[4], bv[4];
#pragma unroll
    for (int j = 0; j < 4; ++j) { gv[j] = *((const GAS f32x4*)g + F.lane + 64 * j); bv[j] = *((const GAS f32x4*)b + F.lane + 64 * j); }
    for (int m = gw; m < M; m += NGW) {
        const GAS f32x4* xr = (const GAS f32x4*)(src + (size_t)m * D) + F.lane;
        f32x4 v[4]; float s = 0.f;
#pragma unroll
        for (int j = 0; j < 4; ++j) { v[j] = xr[64 * j]; s += (v[j].x + v[j].y) + (v[j].z + v[j].w); }
        const float mean = wave_sum(s) * (1.f / D); float s2 = 0.f;
#pragma unroll
        for (int j = 0; j < 4; ++j) { v[j] = v[j] - mean; s2 += (v[j].x * v[j].x + v[j].y * v[j].y) + (v[j].z * v[j].z + v[j].w * v[j].w); }
        const float rstd = 1.f / sqrtf(wave_sum(s2) * (1.f / D) + LN_EPS);
#pragma unroll
        for (int j = 0; j < 4; ++j) { v[j] = v[j] * rstd * gv[j] + bv[j];
            if (dst32) *((GAS f32x4*)(dst32 + (size_t)m * D) + F.lane + 64 * j) = v[j];
            if (dstb) *((GAS unsigned long long*)(dstb + (size_t)m * D) + F.lane + 64 * j) = (unsigned long long)pk2(v[j].x, v[j].y) | ((unsigned long long)pk2(v[j].z, v[j].w) << 32); }
    }
}
__device__ __forceinline__ void conv_gate_rows(Frame& F) {
    const bf16* AP = (const bf16*)(F.ws + WS_AP); bf16* BP = (bf16*)(F.ws + WS_BP); const float* cw = F.in[18]; const float* cb = F.in[19];
    const size_t gid = (size_t)F.vcu * 512 + F.tid, NT = (size_t)F.G * 512, NIT = (size_t)M * (DFF / 8);
    for (size_t idx = gid; idx < NIT; idx += NT) {
        const int m = (int)(idx / (DFF / 8)), c = (int)(idx % (DFF / 8)) * 8, t = m % SEQ;
        float a0[8], a1[8], a2[8], bb[8];
        unpack8(*(const GAS v4u*)(AP + (size_t)m * DFF + c), a0);
        if (t >= 1) unpack8(*(const GAS v4u*)(AP + (size_t)(m - 1) * DFF + c), a1); else {
#pragma unroll
            for (int i = 0; i < 8; ++i) a1[i] = 0.f; }
        if (t >= 2) unpack8(*(const GAS v4u*)(AP + (size_t)(m - 2) * DFF + c), a2); else {
#pragma unroll
            for (int i = 0; i < 8; ++i) a2[i] = 0.f; }
        unpack8(*(const GAS v4u*)(BP + (size_t)m * DFF + c), bb);
        float r[8];
#pragma unroll
        for (int i = 0; i < 8; ++i) { const float y = cw[c + i] * a2[i] + cw[DFF + c + i] * a1[i] + cw[2 * DFF + c + i] * a0[i] + cb[c + i]; r[i] = gelu_tanh(y) * bb[i]; }
        v4u w; w.x = pk2(r[0], r[1]); w.y = pk2(r[2], r[3]); w.z = pk2(r[4], r[5]); w.w = pk2(r[6], r[7]);
        *(GAS v4u*)(BP + (size_t)m * DFF + c) = w;
    }
}


namespace mx {
typedef float f32x16 __attribute__((ext_vector_type(16)));
typedef short v4i16_t __attribute__((ext_vector_type(4)));
constexpr float L2E = 1.4426950408889634f, LN2 = 0.6931471805599453f;
constexpr int KIMG = 0, VIMG = 49152, WSC = 98304, BTL = 98304 + 2048;
__device__ __forceinline__ int crow(int r, int hi) { return (r & 3) + 8 * (r >> 2) + 4 * hi; }
__device__ __forceinline__ void stage_kv(LAS unsigned char* lds, const bf16* Kg, const bf16* Vg, long stride, int nk, int first_valid, int tid) {
    const int chunk = (tid >> 3) & 7, kin = 8 * (tid >> 6) + (tid & 7);
    for (int k0 = 0; k0 < nk; k0 += 64) { const int key = k0 + kin; v4u kv = (v4u){0u, 0u, 0u, 0u}, vv = (v4u){0u, 0u, 0u, 0u};
        if (key >= first_valid) { kv = *(const GAS v4u*)(Kg + (long)key * stride + chunk * 8); vv = *(const GAS v4u*)(Vg + (long)key * stride + chunk * 8); }
        *(LAS v4u*)(lds + KIMG + chunk * (nk * 16) + key * 16) = kv;
        *(LAS v4u*)(lds + VIMG + (chunk >> 2) * (nk * 64) + (key >> 4) * 1024 + (key & 15) * 64 + (chunk & 3) * 16) = vv; }
}
template <int MODE, int NT>
__device__ __forceinline__ void attn_job(LAS unsigned char* lds, int nk, int kt0, int pos0  , const bf16* Qrow  ,
                                         bf16* Orow0  , long ostride  , float* lse_out  ,
                                         int wave, int lane) {
    const int r32 = lane & 31, hi = lane >> 5;
    bf16x8 qr[4];
#pragma unroll
    for (int d0 = 0; d0 < 4; ++d0) qr[d0] = *(const GAS bf16x8*)(Qrow + d0 * 16 + hi * 8);
    const LAS unsigned char* kbase = lds + KIMG + hi * (nk * 16) + r32 * 16;
    const LAS float* btl = (const LAS float*)(lds + BTL);
    const int vlane = ((lane >> 4) & 1) * 32 + (lane & 3) * 8 + (4 * hi + ((lane & 15) >> 2)) * 64;
    float mx = -3.0e38f;
#pragma unroll 1
    for (int j = 0; j < NT; ++j) { const int kb = kt0 + 32 * j; f32x16 p = {0.f, 0.f, 0.f, 0.f, 0.f, 0.f, 0.f, 0.f, 0.f, 0.f, 0.f, 0.f, 0.f, 0.f, 0.f, 0.f};
#pragma unroll
        for (int d0 = 0; d0 < 4; ++d0) { const bf16x8 a = *(const LAS bf16x8*)(kbase + 2 * d0 * (nk * 16) + kb * 16); p = __builtin_amdgcn_mfma_f32_32x32x16_bf16(a, qr[d0], p, 0, 0, 0); }
#pragma unroll
        for (int r = 0; r < 16; ++r) { const int c = crow(r, hi); float s2;
            if (MODE == 1) { const int steps = 128 - 32 * j + r32 - c; const bool ok = (steps >= 0) && (steps <= 128) && (pos0 + kb + c >= 0);
                s2 = ok ? p[r] * L2E + btl[ok ? steps : 0] : -3.0e38f; }
            else s2 = p[r] * L2E;
            mx = fmaxf(mx, s2); } }
    mx = fmaxf(mx, __shfl_xor(mx, 32));
    f32x16 o0 = {0.f, 0.f, 0.f, 0.f, 0.f, 0.f, 0.f, 0.f, 0.f, 0.f, 0.f, 0.f, 0.f, 0.f, 0.f, 0.f}, o1 = o0; float lsum = 0.f;
#pragma unroll 1
    for (int j = 0; j < NT; ++j) { const int kb = kt0 + 32 * j; f32x16 p = {0.f, 0.f, 0.f, 0.f, 0.f, 0.f, 0.f, 0.f, 0.f, 0.f, 0.f, 0.f, 0.f, 0.f, 0.f, 0.f};
#pragma unroll
        for (int d0 = 0; d0 < 4; ++d0) { const bf16x8 a = *(const LAS bf16x8*)(kbase + 2 * d0 * (nk * 16) + kb * 16); p = __builtin_amdgcn_mfma_f32_32x32x16_bf16(a, qr[d0], p, 0, 0, 0); }
        float e[16];
#pragma unroll
        for (int r = 0; r < 16; ++r) { const int c = crow(r, hi);
            if (MODE == 1) { const int steps = 128 - 32 * j + r32 - c; const bool ok = (steps >= 0) && (steps <= 128) && (pos0 + kb + c >= 0);
                const float s2 = p[r] * L2E + btl[ok ? steps : 0]; e[r] = ok ? __builtin_amdgcn_exp2f(s2 - mx) : 0.f; }
            else e[r] = __builtin_amdgcn_exp2f(p[r] * L2E - mx);
            lsum += e[r]; }
#pragma unroll
        for (int ks = 0; ks < 2; ++ks) {
            v4u pw; pw.x = pg8::cvt_pk_bf16(e[8 * ks + 0], e[8 * ks + 1]); pw.y = pg8::cvt_pk_bf16(e[8 * ks + 2], e[8 * ks + 3]); pw.z = pg8::cvt_pk_bf16(e[8 * ks + 4], e[8 * ks + 5]); pw.w = pg8::cvt_pk_bf16(e[8 * ks + 6], e[8 * ks + 7]);
            const bf16x8 pa = __builtin_bit_cast(bf16x8, pw);
#pragma unroll
            for (int dh = 0; dh < 2; ++dh) { const LAS unsigned char* vp = lds + VIMG + dh * (nk * 64) + ((kb >> 4) + ks) * 1024 + vlane;
                const v4i16_t lo = __builtin_amdgcn_ds_read_tr16_b64_v4i16((LAS v4i16_t*)vp), hh = __builtin_amdgcn_ds_read_tr16_b64_v4i16((LAS v4i16_t*)(vp + 512));
                const bf16x8 vf = (bf16x8){lo[0], lo[1], lo[2], lo[3], hh[0], hh[1], hh[2], hh[3]};
                if (dh == 0) o0 = __builtin_amdgcn_mfma_f32_32x32x16_bf16(pa, vf, o0, 0, 0, 0); else o1 = __builtin_amdgcn_mfma_f32_32x32x16_bf16(pa, vf, o1, 0, 0, 0); } } }
    lsum += __shfl_xor(lsum, 32);
    LAS float* wsc = (LAS float*)(lds + WSC + wave * 256);
    if (hi == 0) wsc[r32] = 1.0f / lsum;
    if (lse_out != nullptr && hi == 0) *lse_out = (mx + __builtin_amdgcn_logf(lsum)) * LN2;
    asm volatile("s_waitcnt lgkmcnt(0)" ::: "memory");
#pragma unroll
    for (int r = 0; r < 16; ++r) { const int q = crow(r, hi); const float rl = wsc[q]; bf16* op = Orow0 + (long)q * ostride + r32;
        op[0] = (bf16)f2bf(o0[r] * rl); op[32] = (bf16)f2bf(o1[r] * rl); }
    asm volatile("s_waitcnt lgkmcnt(0)" ::: "memory");
}
}

__device__ __forceinline__ void p2_attn_mfma(Frame& F, bf16* OG, float* LSE) {
    const bf16* QKVA = (const bf16*)(F.ws + WS_QKVA); const float* BT = (const float*)(F.ws + WS_BT);
    LAS unsigned char* lds = F.lds + RING_OFF;
    for (int it = F.vcu; it < 1536; it += F.G) {
        const int g = it / 512, idx = it % 512, b = idx / 64, rem = idx % 64, h = rem / 16, rb = rem % 16;
        const int dil = g == 0 ? 1 : (g == 1 ? 4 : 16); int r, blk;
        if (g == 0) { r = 0; blk = rb; } else if (g == 1) { r = rb >> 2; blk = rb & 3; } else { r = rb; blk = 0; }
        const int i0 = blk * 256, pos0 = i0 - 128; const long stride = (long)dil * QKV_W;
        const bf16* Kg = QKVA + ((long)b * SEQ + (long)pos0 * dil + r) * QKV_W + ATTN_W + g * 256 + h * 64;
        mx::stage_kv(lds, Kg, Kg + ATTN_W, stride, 384, pos0 < 0 ? -pos0 : 0, F.tid);
        if (F.tid < 132) ((LAS float*)(lds + mx::BTL))[F.tid] = F.tid <= 128 ? BT[(g * 4 + h) * 132 + F.tid] * mx::L2E : 0.f;
        __syncthreads();
        const int qpos = i0 + 32 * F.wave;
        const long mq0 = (long)b * SEQ + (long)qpos * dil + r;
        const bf16* Qrow = QKVA + (mq0 + (long)(F.lane & 31) * dil) * QKV_W + g * 256 + h * 64;
        mx::attn_job<1, 5>(lds, 384, 32 * F.wave, pos0, Qrow, OG + ((size_t)g * M + mq0) * 256 + h * 64, (long)dil * 256, LSE + ((size_t)g * M + mq0 + (long)(F.lane & 31) * dil) * 4 + h, F.wave, F.lane);
        __syncthreads();
    }
}
__device__ __forceinline__ void p2_cross_mfma(Frame& F, bf16* OC) {
    const bf16* QC = (const bf16*)(F.ws + WS_QC); const bf16* KVM = (const bf16*)(F.ws + WS_KVM);
    LAS unsigned char* lds = F.lds + RING_OFF;
    for (int it = F.vcu; it < 512; it += F.G) {
        const int b = it / 64, h = (it % 64) / 16, blk = it % 16;
        const bf16* Kg = KVM + (size_t)b * MEM_LEN * 512 + h * 64;
        mx::stage_kv(lds, Kg, Kg + 256, 512, 256, 0, F.tid);
        __syncthreads();
        const long mq0 = (long)b * SEQ + blk * 256 + 32 * F.wave;
        mx::attn_job<0, 8>(lds, 256, 0, 0, QC + (mq0 + (F.lane & 31)) * 256 + h * 64, OC + (size_t)mq0 * 256 + h * 64, 256, nullptr, F.wave, F.lane);
        __syncthreads();
    }
}
__device__ __forceinline__ void p2_combine(Frame& F, const bf16* OG, const float* LSE, bf16* OA) {
    const size_t gid = (size_t)F.vcu * 512 + F.tid, NT = (size_t)F.G * 512;
    for (size_t i = gid; i < (size_t)M * 32; i += NT) { const size_t m = i >> 5; const int h = (int)(i >> 3) & 3, c = (int)i & 7;
        const float l0 = LSE[m * 4 + h], l1 = LSE[((size_t)M + m) * 4 + h], l2 = LSE[((size_t)2 * M + m) * 4 + h];
        const float lm = fmaxf(l0, fmaxf(l1, l2)); float w0 = __expf(l0 - lm), w1 = __expf(l1 - lm), w2 = __expf(l2 - lm); const float ws = 1.0f / (w0 + w1 + w2); w0 *= ws; w1 *= ws; w2 *= ws;
        float a[8], b2[8], c2[8]; const size_t off = m * 256 + h * 64 + c * 8;
        unpack8(*(const GAS v4u*)(OG + off), a); unpack8(*(const GAS v4u*)(OG + (size_t)M * 256 + off), b2); unpack8(*(const GAS v4u*)(OG + (size_t)2 * M * 256 + off), c2);
        float r[8];
#pragma unroll
        for (int k = 0; k < 8; ++k) r[k] = w0 * a[k] + w1 * b2[k] + w2 * c2[k];
        v4u w; w.x = pk2(r[0], r[1]); w.y = pk2(r[2], r[3]); w.z = pk2(r[4], r[5]); w.w = pk2(r[6], r[7]);
        *(GAS v4u*)(OA + off) = w; }
}
__device__ __forceinline__ void p2_spatial_mfma(Frame& F, bf16* OB) {
    const bf16* ZB = (const bf16*)(F.ws + WS_ZB);
    LAS unsigned char* lds = F.lds + RING_OFF;
    LAS float* st = (LAS float*)(lds + 65536);
    const float* lng = F.in[5]; const float* lnb = F.in[6]; const float* wsp = F.in[7]; const float* bsp = F.in[8];
    const int lane = F.lane, r32 = lane & 31, hi = lane >> 5, pt = F.wave & 3, dh = F.wave >> 2;
    const int vlane = ((lane >> 4) & 1) * 32 + (lane & 3) * 8 + (4 * hi + ((lane & 15) >> 2)) * 64;
    for (int item = F.vcu; item < M / 128; item += F.G) {
        const int m0 = item * 128;
        for (int i = 0; i < 16; ++i) { const int tok = F.wave * 16 + i; float f[8]; unpack8(*(const GAS v4u*)(ZB + (size_t)(m0 + tok) * 1024 + 512 + lane * 8), f);
            float s = 0.f;
#pragma unroll
            for (int k = 0; k < 8; ++k) s += f[k];
            const float mean = wave_sum(s) * (1.0f / 512.0f); float s2 = 0.f;
#pragma unroll
            for (int k = 0; k < 8; ++k) { const float dd = f[k] - mean; s2 += dd * dd; }
            const float rstd = 1.0f / sqrtf(wave_sum(s2) * (1.0f / 512.0f) + LN_EPS);
            if (lane == 0) { st[tok * 2] = mean; st[tok * 2 + 1] = rstd; } }
        __syncthreads();
        for (int g = 0; g < 8; ++g) {
            LAS unsigned char* img = lds + (g & 1) * 16384;
#pragma unroll
            for (int pc = 0; pc < 2; ++pc) { const int piece = F.tid + 512 * pc, q = piece >> 3, ch = piece & 7; float f[8]; unpack8(*(const GAS v4u*)(ZB + (size_t)(m0 + q) * 1024 + 512 + g * 64 + ch * 8), f);
                const float mean = st[2 * q], rstd = st[2 * q + 1]; float y[8];
#pragma unroll
                for (int k = 0; k < 8; ++k) y[k] = (f[k] - mean) * rstd * lng[g * 64 + ch * 8 + k] + lnb[g * 64 + ch * 8 + k];
                v4u w; w.x = pk2(y[0], y[1]); w.y = pk2(y[2], y[3]); w.z = pk2(y[4], y[5]); w.w = pk2(y[6], y[7]);
                *(LAS v4u*)(img + (ch >> 2) * 8192 + (q >> 4) * 1024 + (q & 15) * 64 + (ch & 3) * 16) = w; }
            __syncthreads();
            mx::f32x16 o = {0.f, 0.f, 0.f, 0.f, 0.f, 0.f, 0.f, 0.f, 0.f, 0.f, 0.f, 0.f, 0.f, 0.f, 0.f, 0.f};
            const int p = pt * 32 + r32; const float* wrow = wsp + ((size_t)g * 128 + p) * 128;
#pragma unroll
            for (int ks = 0; ks < 8; ++ks) { if (ks <= 2 * pt + 1) {
                const int qa = 16 * ks + 4 * hi, qb = qa + 8;
                f32x4 wa = *(const GAS f32x4*)(wrow + qa), wb = *(const GAS f32x4*)(wrow + qb);
#pragma unroll
                for (int k = 0; k < 4; ++k) { if (qa + k > p) wa[k] = 0.f; if (qb + k > p) wb[k] = 0.f; }
                v4u pw; pw.x = pk2(wa[0], wa[1]); pw.y = pk2(wa[2], wa[3]); pw.z = pk2(wb[0], wb[1]); pw.w = pk2(wb[2], wb[3]);
                const LAS unsigned char* vp = img + dh * 8192 + ks * 1024 + vlane;
                const mx::v4i16_t lo = __builtin_amdgcn_ds_read_tr16_b64_v4i16((LAS mx::v4i16_t*)vp), hh = __builtin_amdgcn_ds_read_tr16_b64_v4i16((LAS mx::v4i16_t*)(vp + 512));
                const bf16x8 vf = (bf16x8){lo[0], lo[1], lo[2], lo[3], hh[0], hh[1], hh[2], hh[3]};
                o = __builtin_amdgcn_mfma_f32_32x32x16_bf16(__builtin_bit_cast(bf16x8, pw), vf, o, 0, 0, 0); } }
            const int e = 32 * dh + r32;
#pragma unroll
            for (int r = 0; r < 16; ++r) { const int pp = pt * 32 + mx::crow(r, hi); const float u = bf2f(ZB[(size_t)(m0 + pp) * 1024 + g * 64 + e]);
                OB[(size_t)(m0 + pp) * 512 + g * 64 + e] = (bf16)f2bf(u * (o[r] + bsp[g * 128 + pp])); }
        }
        __syncthreads();
    }
}

#if defined(MK_DIAG)
__device__ __forceinline__ float dot_bf16(const bf16* a, const bf16* b, int K) {
    float s = 0.f;
    for (int k = 0; k < K; k += 8) { float fa[8], fb[8]; unpack8(*(const GAS v4u*)(a + k), fa); unpack8(*(const GAS v4u*)(b + k), fb);
#pragma unroll
        for (int i = 0; i < 8; ++i) s += fa[i] * fb[i]; }
    return s;
}
__device__ __forceinline__ void chk_note(Frame& F, int slot, float ratio) {
    float r = ratio;
#pragma unroll
    for (int o = 1; o < 64; o <<= 1) r = fmaxf(r, __shfl_xor(r, o));
    if (F.lane == 0 && r > 0.f) atomicMax((unsigned*)(F.ctl + 512 + 64 * slot), __float_as_uint(r));
}
__device__ __forceinline__ void chk0(Frame& F) {
    const size_t gid = (size_t)F.vcu * 512 + F.tid, NT = (size_t)F.G * 512; unsigned char* ws = F.ws; float worst = 0.f;
#define CHKW(W, Kd, Nd, WT, ldt, mode) for (size_t i = gid; i < (size_t)(Kd) * (Nd); i += NT) { const int k = (int)(i / (Nd)), n = (int)(i % (Nd)); int r = n; \
        if (mode == 1) r = (n < DFF) ? (256 * (n / 128) + n % 128) : (256 * ((n - DFF) / 128) + 128 + (n - DFF) % 128); \
        const float e = __uint_as_float(f2bf((W)[i]) << 16), a = bf2f(((const bf16*)(ws + (WT)))[(size_t)r * (ldt) + k]); worst = fmaxf(worst, fabsf(e - a) * 1e4f); }
    CHKW(F.in[3], D, IN_W, WS_WIN, D, 0) CHKW(F.in[12], D, GATE_W, WS_WG, D, 0) CHKW(F.in[4], D, 512, WS_WMKV, D, 0)
    CHKW(F.in[9], 256, D, WS_WA, 256, 0) CHKW(F.in[10], 512, D, WS_WB, 512, 0) CHKW(F.in[11], 256, D, WS_WC, 256, 0)
    CHKW(F.in[14], D, D, WS_WOUT, D, 0) CHKW(F.in[17], D, UP_W, WS_WUP, D, 1) CHKW(F.in[20], DFF, D, WS_WDN, DFF, 0)
#undef CHKW
    for (size_t i = gid; i < (size_t)M * D; i += NT) { const float e = __uint_as_float(f2bf(F.in[0][i]) << 16), a = bf2f(((const bf16*)(ws + WS_XB))[i]); worst = fmaxf(worst, fabsf(e - a) * 1e4f); }
    for (size_t i = gid; i < (size_t)BATCH * MEM_LEN * D; i += NT) { const float e = __uint_as_float(f2bf(F.in[1][i]) << 16), a = bf2f(((const bf16*)(ws + WS_MEMB))[i]); worst = fmaxf(worst, fabsf(e - a) * 1e4f); }
    chk_note(F, 0, worst);
}
__device__ __forceinline__ void chk1(Frame& F) {
    const size_t gid = (size_t)F.vcu * 512 + F.tid, NT = (size_t)F.G * 512; unsigned char* ws = F.ws; float worst = 0.f;
    const bf16* XB = (const bf16*)(ws + WS_XB); const bf16* WIN = (const bf16*)(ws + WS_WIN);
    for (size_t i = gid; i < (size_t)(M / 3) * IN_W; i += NT) { const int m = 3 * (int)(i / IN_W), n = (int)(i % IN_W);
        const float acc = dot_bf16(XB + (size_t)m * D, WIN + (size_t)n * D, D); float e, a;
        if (n < QKV_W) { e = n < ATTN_W ? acc * 0.125f : acc; a = bf2f(((const bf16*)(ws + WS_QKVA))[(size_t)m * QKV_W + n]); }
        else if (n < QKV_W + 1024) { e = gelu_tanh(acc); a = bf2f(((const bf16*)(ws + WS_ZB))[(size_t)m * 1024 + n - QKV_W]); }
        else { e = acc * 0.125f; a = bf2f(((const bf16*)(ws + WS_QC))[(size_t)m * 256 + n - QKV_W - 1024]); }
        worst = fmaxf(worst, fabsf(e - a) / (0.02f + 0.01f * fabsf(e))); }
    chk_note(F, 1, worst); worst = 0.f;
    for (size_t i = gid; i < (size_t)BATCH * MEM_LEN * 512; i += NT) { const int m = (int)(i / 512), n = (int)(i % 512);
        const float e = dot_bf16((const bf16*)(ws + WS_MEMB) + (size_t)m * D, (const bf16*)(ws + WS_WMKV) + (size_t)n * D, D), a = bf2f(((const bf16*)(ws + WS_KVM))[i]);
        worst = fmaxf(worst, fabsf(e - a) / (0.02f + 0.01f * fabsf(e))); }
    chk_note(F, 2, worst);
}
__device__ __forceinline__ void chk3a(Frame& F) {
    const size_t gid = (size_t)F.vcu * 512 + F.tid, NT = (size_t)F.G * 512; unsigned char* ws = F.ws; float worst = 0.f;
    for (size_t i = gid; i < (size_t)(M / 3) * GATE_W; i += NT) { const int m = 3 * (int)(i / GATE_W), n = (int)(i % GATE_W);
        const float acc = dot_bf16((const bf16*)(ws + WS_XB) + (size_t)m * D, (const bf16*)(ws + WS_WG) + (size_t)n * D, D) + F.in[13][n];
        const float e = 1.0f / (1.0f + expf(-acc)), a = bf2f(((const bf16*)(ws + WS_GATES))[(size_t)m * GATE_W + n]); worst = fmaxf(worst, fabsf(e - a) / 0.01f);  if (fabsf(e - a) > 0.02f) { atomicAdd((unsigned*)(F.ctl + 512 + 64 * 8), 1u); atomicMin((unsigned*)(F.ctl + 512 + 64 * 9), 0x7fffffffu - (unsigned)(i)); } }
    chk_note(F, 3, worst);
}
__device__ __forceinline__ void chk3b(Frame& F) {
    const size_t gid = (size_t)F.vcu * 512 + F.tid, NT = (size_t)F.G * 512; unsigned char* ws = F.ws; float worst = 0.f; const bf16* GT = (const bf16*)(ws + WS_GATES);
    for (size_t i = gid; i < (size_t)M * D; i += NT) { const int m = (int)(i / D), n = (int)(i % D);
        const float pa = dot_bf16((const bf16*)(ws + WS_OA) + (size_t)m * 256, (const bf16*)(ws + WS_WA) + (size_t)n * 256, 256);
        const float pb = dot_bf16((const bf16*)(ws + WS_OB) + (size_t)m * 512, (const bf16*)(ws + WS_WB) + (size_t)n * 512, 512);
        const float pc = dot_bf16((const bf16*)(ws + WS_OC) + (size_t)m * 256, (const bf16*)(ws + WS_WC) + (size_t)n * 256, 256);
        const float e = bf2f(GT[(size_t)m * GATE_W + n]) * pa + bf2f(GT[(size_t)m * GATE_W + 1024 + n]) * pb + bf2f(GT[(size_t)m * GATE_W + 2048 + n]) * pc;
        const float a = bf2f(((const bf16*)(ws + WS_MERGED))[i]); worst = fmaxf(worst, fabsf(e - a) / (0.01f + 0.01f * fabsf(e))); }
    chk_note(F, 4, worst);
}
__device__ __forceinline__ void chk4(Frame& F) {
    const size_t gid = (size_t)F.vcu * 512 + F.tid, NT = (size_t)F.G * 512; unsigned char* ws = F.ws; float worst = 0.f;
    for (size_t i = gid; i < (size_t)M * D; i += NT) { const int m = (int)(i / D), n = (int)(i % D);
        const float e = ALPHA * F.in[0][i] + dot_bf16((const bf16*)(ws + WS_MERGED) + (size_t)m * D, (const bf16*)(ws + WS_WOUT) + (size_t)n * D, D);
        worst = fmaxf(worst, fabsf(e - F.out[i]) / 1e-3f); }
    chk_note(F, 5, worst);
}
__device__ __forceinline__ void chk5(Frame& F) {
    const size_t gid = (size_t)F.vcu * 512 + F.tid, NT = (size_t)F.G * 512; unsigned char* ws = F.ws; float worst = 0.f;
    for (size_t i = gid; i < (size_t)(M / 3) * UP_W; i += NT) { const int m = 3 * (int)(i / UP_W), r = (int)(i % UP_W), pn = r >> 8, c = r & 255;
        const float e = dot_bf16((const bf16*)(ws + WS_HB) + (size_t)m * D, (const bf16*)(ws + WS_WUP) + (size_t)r * D, D);
        const float a = c < 128 ? bf2f(((const bf16*)(ws + WS_AP))[(size_t)m * DFF + pn * 128 + c]) : bf2f(((const bf16*)(ws + WS_BP))[(size_t)m * DFF + pn * 128 + c - 128]);
        worst = fmaxf(worst, fabsf(e - a) / (0.02f + 0.01f * fabsf(e))); }
    chk_note(F, 6, worst);
}
__device__ __forceinline__ void chk6(Frame& F) {
    const size_t gid = (size_t)F.vcu * 512 + F.tid, NT = (size_t)F.G * 512; unsigned char* ws = F.ws; float worst = 0.f;
    for (size_t i0 = gid; i0 < (size_t)(M / 3) * D; i0 += NT) { const int m = 3 * (int)(i0 / D), n = (int)(i0 % D); const size_t i = (size_t)m * D + n;
        const float e = ALPHA * bf2f(((const bf16*)(ws + WS_HB))[i]) + dot_bf16((const bf16*)(ws + WS_BP) + (size_t)m * DFF, (const bf16*)(ws + WS_WDN) + (size_t)n * DFF, DFF);
        worst = fmaxf(worst, fabsf(e - F.out[i]) / 0.05f); }
    chk_note(F, 7, worst);
}

__device__ __forceinline__ void chk_mix(Frame& F) {
    const size_t gid = (size_t)F.vcu * 512 + F.tid, NT = (size_t)F.G * 512; unsigned char* ws = F.ws; float wa = 0.f, wb = 0.f, wc = 0.f;
    for (size_t i = gid; i < (size_t)M * 256; i += NT) { const float a = bf2f(((const bf16*)(ws + WS_OA))[i]), b = bf2f(((const bf16*)(ws + WS_OA2))[i]); wa = fmaxf(wa, fabsf(a - b) / (0.002f + 0.02f * fabsf(a)));
        const float c = bf2f(((const bf16*)(ws + WS_OC))[i]), d = bf2f(((const bf16*)(ws + WS_OC2))[i]); wc = fmaxf(wc, fabsf(c - d) / (0.002f + 0.02f * fabsf(c))); }
    for (size_t i = gid; i < (size_t)M * 512; i += NT) { const float a = bf2f(((const bf16*)(ws + WS_OB))[i]), b = bf2f(((const bf16*)(ws + WS_OB2))[i]); wb = fmaxf(wb, fabsf(a - b) / 0.1f); }
    chk_note(F, 0, wa); chk_note(F, 1, wc); chk_note(F, 2, wb);
}
__device__ __forceinline__ void chk_fin(Frame& F) {
    if (blockIdx.x == 0 && F.tid == 0) { int first = -1; float rmax = 0.f;
        for (int s = 0; s < 8; ++s) { const float r = __uint_as_float(__hip_atomic_load(F.ctl + 512 + 64 * s, RLX_AGENT)); if (r > 1.0f && first < 0) first = s; if (s == MK_DIAG_SLOT) rmax = r; }
#if MK_DIAG_SLOT == 8
        F.out[0] += 100.0f * (float)__hip_atomic_load(F.ctl + 512 + 64 * 8, RLX_AGENT);
#elif MK_DIAG_SLOT >= 0
        F.out[0] += 100.0f * rmax;
#else
        F.out[0] += 100.0f * (float)(first + 1);
#endif
    }
}
#endif

struct Args { const float* in[23]; float* out; unsigned char* ws; int ph_lo, ph_hi, li, pad; };
__global__ void __launch_bounds__(NWAVES * 64, 2) mk_fwd(Args args) {
    extern __shared__ __attribute__((aligned(16))) unsigned char lds[];
    Frame F;
    F.lds = (LAS unsigned char*)lds;
    F.MISC = (volatile LAS unsigned*)(F.lds + MISC_OFF);
    F.tid = threadIdx.x; F.lane = F.tid & 63; F.wave = __builtin_amdgcn_readfirstlane(F.tid >> 6);
    F.G = gridDim.x; { const int bx = blockIdx.x; F.vcu = (F.G % 8 == 0) ? (bx % 8) * (F.G / 8) + bx / 8 : bx; }
    unsigned char* ws = args.ws; F.ws = ws; F.out = args.out;
#pragma unroll
    for (int i = 0; i < 23; ++i) F.in[i] = args.in[i];
    F.ctl = (gu32*)(ws + WS_CTL);
    for (int u = F.tid; u < (LDS_BYTES - LDSCTL_OFF) / 4; u += NWAVES * 64) ((LAS unsigned*)(F.lds + LDSCTL_OFF))[u] = 0u;
    __syncthreads();
    XcdBarrier bar; bar.bar = (unsigned*)(F.ctl + CW_BAR); bar.x = 0; bar.st = nullptr;
    if (N_LAUNCHES == 1) bar = xcd_barrier_post((unsigned*)(F.ctl + CW_BAR), F.MISC + 8);
#define GRID_BAR() do { if (N_LAUNCHES == 1) { xcd_barrier(bar); } } while (0)
    const int lo = args.ph_lo, hi = args.ph_hi;
#define IN(k) (lo <= (k) && (k) < hi)
#define BOTH(k) (IN(k) && IN((k) + 1))
    const int G = F.G, bx = (int)blockIdx.x;
#if defined(MK_DIAG)
    if (args.pad != 0) { switch (args.pad) { case 1: chk0(F); break; case 2: chk1(F); break; case 3: chk3a(F); break; case 4: chk3b(F); break; case 5: chk4(F); break; case 6: chk5(F); break; case 7: chk6(F); break; case 20: p2_attn_mfma(F, (bf16*)(ws + WS_OG), (float*)(ws + WS_LSE)); p2_cross_mfma(F, (bf16*)(ws + WS_OC2)); p2_spatial_mfma(F, (bf16*)(ws + WS_OB2)); break; case 21: p2_combine(F, (const bf16*)(ws + WS_OG), (const float*)(ws + WS_LSE), (bf16*)(ws + WS_OA2)); break; case 22: chk_mix(F); break; default: chk_fin(F); break; } return; }
#endif

    if (IN(0)) { p0_prologue(F); if (BOTH(0)) GRID_BAR(); }

    if (IN(1)) {
        { pg8::Gemm g{(const bf16*)(ws + WS_XB), (const bf16*)(ws + WS_WIN), M, IN_W, D}; pg8::StaticOrder S; S.init(M, IN_W, G, bx);
          pg8::EpiProj E{(bf16*)(ws + WS_QKVA), (bf16*)(ws + WS_ZB), (bf16*)(ws + WS_QC)};
          pg8::gemm_phase<pg8::EpiProj, pg8::StaticOrder, true, true>(F.lds + RING_OFF, g, S, E); }
        { pg8::Gemm g{(const bf16*)(ws + WS_MEMB), (const bf16*)(ws + WS_WMKV), BATCH * MEM_LEN, 512, D}; pg8::StaticOrder S; S.init(BATCH * MEM_LEN, 512, G, bx);
          pg8::EpiPlain E{(bf16*)(ws + WS_KVM), 512};
          pg8::gemm_phase<pg8::EpiPlain, pg8::StaticOrder, true, true>(F.lds + RING_OFF, g, S, E); }
        if (BOTH(1)) GRID_BAR();
    }
    if (IN(2)) {
#if defined(MK_SIMPLE_MIXERS)
        p2_attn_simple(F); p2_cross_simple(F); p2_spatial_simple(F);
#else
        p2_attn_mfma(F, (bf16*)(ws + WS_OG), (float*)(ws + WS_LSE)); p2_cross_mfma(F, (bf16*)(ws + WS_OC)); p2_spatial_mfma(F, (bf16*)(ws + WS_OB));
#endif
        if (BOTH(2)) GRID_BAR();
    }
    if (IN(3)) {
#if !defined(MK_SIMPLE_MIXERS)
        p2_combine(F, (const bf16*)(ws + WS_OG), (const float*)(ws + WS_LSE), (bf16*)(ws + WS_OA));
#endif
        pg8::Gemm g{(const bf16*)(ws + WS_XB), (const bf16*)(ws + WS_WG), M, GATE_W, D}; pg8::StaticOrder S; S.init(M, GATE_W, G, bx);
        pg8::EpiGate E{(bf16*)(ws + WS_GATES), GATE_W, F.in[13]};
        pg8::gemm_phase<pg8::EpiGate, pg8::StaticOrder, true, true>(F.lds + RING_OFF, g, S, E);
        if (BOTH(3)) GRID_BAR();
    }
    if (IN(4)) {
        { pg8::Gemm g{(const bf16*)(ws + WS_OA), (const bf16*)(ws + WS_WA), M, D, 256}; pg8::StaticOrder S; S.init(M, D, G, bx);
          pg8::EpiMerge E{(const bf16*)(ws + WS_GATES), F.out, (bf16*)(ws + WS_MERGED), 0};
          pg8::gemm_phase<pg8::EpiMerge, pg8::StaticOrder, true, true>(F.lds + RING_OFF, g, S, E); }
        { pg8::Gemm g{(const bf16*)(ws + WS_OB), (const bf16*)(ws + WS_WB), M, D, 512}; pg8::StaticOrder S; S.init(M, D, G, bx);
          pg8::EpiMerge E{(const bf16*)(ws + WS_GATES), F.out, (bf16*)(ws + WS_MERGED), 1};
          pg8::gemm_phase<pg8::EpiMerge, pg8::StaticOrder, true, true>(F.lds + RING_OFF, g, S, E); }
        { pg8::Gemm g{(const bf16*)(ws + WS_OC), (const bf16*)(ws + WS_WC), M, D, 256}; pg8::StaticOrder S; S.init(M, D, G, bx);
          pg8::EpiMerge E{(const bf16*)(ws + WS_GATES), F.out, (bf16*)(ws + WS_MERGED), 2};
          pg8::gemm_phase<pg8::EpiMerge, pg8::StaticOrder, true, true>(F.lds + RING_OFF, g, S, E); }
        if (BOTH(4)) GRID_BAR();
    }
    if (IN(5)) {
        pg8::Gemm g{(const bf16*)(ws + WS_MERGED), (const bf16*)(ws + WS_WOUT), M, D, D}; pg8::StaticOrder S; S.init(M, D, G, bx);
        pg8::EpiResid E{F.in[0], F.out, D, ALPHA};
        pg8::gemm_phase<pg8::EpiResid, pg8::StaticOrder, true, true>(F.lds + RING_OFF, g, S, E);
        if (BOTH(5)) GRID_BAR();
    }
    if (IN(6)) { ln_rows(F, F.out, F.out, (bf16*)(ws + WS_HB), F.in[15], F.in[16]); if (BOTH(6)) GRID_BAR(); }
    if (IN(7)) {
        pg8::Gemm g{(const bf16*)(ws + WS_HB), (const bf16*)(ws + WS_WUP), M, UP_W, D}; pg8::StaticOrder S; S.init(M, UP_W, G, bx);
        pg8::EpiUp E{(bf16*)(ws + WS_AP), (bf16*)(ws + WS_BP), DFF};
        pg8::gemm_phase<pg8::EpiUp, pg8::StaticOrder, true, true>(F.lds + RING_OFF, g, S, E);
        if (BOTH(7)) GRID_BAR();
    }
    if (IN(8)) { conv_gate_rows(F); if (BOTH(8)) GRID_BAR(); }
    if (IN(9)) {
        pg8::Gemm g{(const bf16*)(ws + WS_BP), (const bf16*)(ws + WS_WDN), M, D, DFF}; pg8::StaticOrder S; S.init(M, D, G, bx);
        pg8::EpiResid E{F.out, F.out, D, ALPHA};
        pg8::gemm_phase<pg8::EpiResid, pg8::StaticOrder, true, true>(F.lds + RING_OFF, g, S, E);
        if (BOTH(9)) GRID_BAR();
    }
    if (IN(10)) { ln_rows(F, F.out, F.out, nullptr, F.in[21], F.in[22]); }
#undef IN
#undef BOTH
}

extern "C" void kernel_launch(void* const* d_in, const int* in_sizes, int n_in, void* d_out, int out_size, void* d_ws, size_t ws_size, hipStream_t stream) {
    static int grid = 0;
    if (grid == 0) {
        if (n_in != 23 || in_sizes[0] != M * D || out_size != M * D || ws_size < WS_TOTAL) { fprintf(stderr, "kernel_launch: unexpected shapes: n_in %d in0 %d out %d ws %zu\n", n_in, n_in > 0 ? in_sizes[0] : -1, out_size, ws_size); grid = -1; return; }
        int dev = 0, cus = 0, per_cu = 0;
        if (hipGetDevice(&dev) != hipSuccess || hipDeviceGetAttribute(&cus, hipDeviceAttributeMultiprocessorCount, dev) != hipSuccess) { grid = -1; return; }
        if (hipFuncSetAttribute((const void*)mk_fwd, hipFuncAttributeMaxDynamicSharedMemorySize, LDS_BYTES) != hipSuccess) { fprintf(stderr, "kernel_launch: hipFuncSetAttribute failed\n"); grid = -1; return; }
        if (hipOccupancyMaxActiveBlocksPerMultiprocessor(&per_cu, (const void*)mk_fwd, NWAVES * 64, LDS_BYTES) != hipSuccess || per_cu < 1)
            fprintf(stderr, "kernel_launch: note: occupancy query reports %d workgroups per CU\n", per_cu);
        (void)hipGetLastError();
        grid = cus;
    }
    if (grid < 0) return;
    if (hipMemsetAsync((char*)d_ws + WS_CTL, 0, CTL_ZERO_BYTES, stream) != hipSuccess) { fprintf(stderr, "kernel_launch: hipMemsetAsync failed\n"); return; }
    Args a{};
    for (int i = 0; i < 23; ++i) a.in[i] = (const float*)d_in[i];
    a.out = (float*)d_out; a.ws = (unsigned char*)d_ws;
#if defined(MK_DIAG)
    { static const int tab[][2] = {{0,0},{1,0},{2,0},{-1,20},{-1,21},{-1,22},{3,0},{4,0},{5,0},{6,0},{7,0},{8,0},{9,0},{10,0},{-1,8}};
      for (unsigned li = 0; li < sizeof(tab) / sizeof(tab[0]); ++li) { a.ph_lo = tab[li][0] < 0 ? 0 : tab[li][0]; a.ph_hi = tab[li][0] < 0 ? 0 : tab[li][0] + 1; a.li = 0; a.pad = tab[li][1];
        hipLaunchKernelGGL(mk_fwd, dim3(grid), dim3(NWAVES * 64), LDS_BYTES, stream, a); } }
#else
    for (int li = 0; li < N_LAUNCHES; ++li) {
        a.ph_lo = (N_LAUNCHES == 1) ? 0 : li; a.ph_hi = (N_LAUNCHES == 1) ? N_PHASES : li + 1; a.li = li;
        hipLaunchKernelGGL(mk_fwd, dim3(grid), dim3(NWAVES * 64), LDS_BYTES, stream, a);
        const hipError_t le = hipPeekAtLastError();
        if (le != hipSuccess) { fprintf(stderr, "kernel_launch: launch %d failed: %s\n", li, hipGetErrorName(le)); break; }
    }
#endif
}
```
